# Optimizing an MI355X kernel written in HIP

```python
import jax, jax.numpy as jnp
from jax import lax
import numpy as np

D_MODEL = 1024
BATCH = 32
SEQ = 256
DEPTH = 4
DEC_BATCH = 4
DEC_SEQ = 2048
PAST_LEN = 512

GRID_W = 64
N_MIXERS = 3
N_MLA = (DEPTH + 2) // 3
N_CONV = (DEPTH + 1) // 3
N_RET = DEPTH // 3

MLA_HEADS = 8
MLA_NOPE = 128
MLA_ROPE = 64
MLA_V = 128
MLA_Q_RANK = 384
MLA_KV_RANK = 256
MLA_SCALE = (MLA_NOPE + MLA_ROPE) ** -0.5
ROPE_THETA = 10000.0
ROPE_AXIS_FREQS = MLA_ROPE // 4
Q_BLOCK = 128

CONV_WIDTH = 3

RET_HEADS = 4
RET_DK = D_MODEL // RET_HEADS
RET_DV = 2 * RET_DK
RET_CHUNK = 128

FFN_HIDDEN = -(-8 * D_MODEL // (3 * 256)) * 256
EPS = 1e-6

kernel_name = 'hybrid_diffusion_mla_conv_retention_step'


def rmsnorm(x, g):
    xf = x.astype(jnp.float32)
    y = xf * lax.rsqrt(jnp.mean(xf * xf, axis=-1, keepdims=True) + EPS)
    return (y * g.astype(jnp.float32)).astype(x.dtype)


def modulate(x, g, shift, scale):
    return rmsnorm(x, g) * (1 + scale) + shift


def axial_rope_tables(n_tokens):
    rows = n_tokens // GRID_W
    r = jnp.repeat(jnp.arange(rows, dtype=jnp.float32), GRID_W)
    col = jnp.tile(jnp.arange(GRID_W, dtype=jnp.float32), rows)
    inv = ROPE_THETA ** (-jnp.arange(ROPE_AXIS_FREQS, dtype=jnp.float32) / ROPE_AXIS_FREQS)
    ang = jnp.stack([r[:, None] * inv, col[:, None] * inv], axis=1)
    return jnp.cos(ang), jnp.sin(ang)


def apply_axial_rope(x, cos, sin):
    xr = x.reshape(x.shape[:-1] + (2, 2, ROPE_AXIS_FREQS))
    x1, x2 = xr[..., 0, :], xr[..., 1, :]
    cos = cos.astype(x.dtype)
    sin = sin.astype(x.dtype)
    out = jnp.stack([x1 * cos - x2 * sin, x2 * cos + x1 * sin], axis=-2)
    return out.reshape(x.shape)


def mla_project(h, w_a, q_norm_g, kv_norm_g, w_q_b):
    B, S, _ = h.shape
    a = h @ w_a
    q_a, ckv, k_pe = jnp.split(a, [MLA_Q_RANK, MLA_Q_RANK + MLA_KV_RANK], axis=-1)
    q = (rmsnorm(q_a, q_norm_g) @ w_q_b).reshape(B, S, MLA_HEADS, MLA_NOPE + MLA_ROPE)
    return q[..., :MLA_NOPE], q[..., MLA_NOPE:], rmsnorm(ckv, kv_norm_g), k_pe


def mla_expand(ckv, w_kv_b):
    B, S, _ = ckv.shape
    kv = (ckv @ w_kv_b).reshape(B, S, MLA_HEADS, MLA_NOPE + MLA_V)
    return kv[..., :MLA_NOPE], kv[..., MLA_NOPE:]


def mla_attend(q_nope, q_pe, k_nope, k_pe, v, w_o):
    B, Sq = q_nope.shape[:2]
    nb = Sq // Q_BLOCK

    def to_blocks(t):
        return t.reshape((B, nb, Q_BLOCK) + t.shape[2:]).swapaxes(0, 1)

    def one_block(args):
        qn, qp = args
        s = (jnp.einsum('bqhd,bkhd->bhqk', qn, k_nope)
             + jnp.einsum('bqhr,bkr->bhqk', qp, k_pe))
        p = jax.nn.softmax(s.astype(jnp.float32) * MLA_SCALE, axis=-1).astype(v.dtype)
        return jnp.einsum('bhqk,bkhd->bqhd', p, v)

    o = lax.map(one_block, (to_blocks(q_nope), to_blocks(q_pe)))
    return o.swapaxes(0, 1).reshape(B, Sq, MLA_HEADS * MLA_V) @ w_o


def short_conv_mixer(h, w_in, conv_w, w_out):
    b_gate, c_gate, u = jnp.split(h @ w_in, 3, axis=-1)
    z = c_gate * u
    S = z.shape[1]
    zp = jnp.pad(z, ((0, 0), (1, 1), (0, 0)))
    conv = zp[:, :S] * conv_w[0] + zp[:, 1:S + 1] * conv_w[1] + zp[:, 2:] * conv_w[2]
    return (b_gate * conv) @ w_out


def retention_scan(q, k, v, log_gamma, s0):
    B, S, H, _ = q.shape
    n = S // RET_CHUNK
    idx = jnp.arange(RET_CHUNK, dtype=jnp.float32)
    diff = idx[:, None] - idx[None, :]
    intra = jnp.where(diff[None] >= 0,
                      jnp.exp(jnp.maximum(diff, 0.0)[None] * log_gamma[:, None, None]), 0.0)
    q_decay = jnp.exp((idx[:, None] + 1.0) * log_gamma[None])
    k_decay = jnp.exp((RET_CHUNK - 1.0 - idx)[:, None] * log_gamma[None])
    chunk_decay = jnp.exp(RET_CHUNK * log_gamma)

    def chunks(t):
        return t.reshape((B, n, RET_CHUNK) + t.shape[2:]).swapaxes(0, 1)

    def step(state, qkv):
        qc, kc, vc = qkv
        scores = jnp.einsum('bihd,bjhd->bhij', qc, kc) * intra
        inner = jnp.einsum('bhij,bjhe->bihe', scores, vc)
        cross = jnp.einsum('bihd,bhde->bihe', qc, state) * q_decay[None, :, :, None]
        new_state = (state * chunk_decay[None, :, None, None]
                     + jnp.einsum('bjhd,bjhe->bhde', kc * k_decay[None, :, :, None], vc))
        return new_state, inner + cross

    s_final, o = lax.scan(step, s0, (chunks(q), chunks(k), chunks(v)))
    return o.swapaxes(0, 1).reshape(B, S, H, v.shape[-1]), s_final


def retention_mixer(h, w_in, log_rate, gn_g, w_out, s0_fwd, s0_bwd):
    B, S, _ = h.shape
    f32 = jnp.float32
    hk, hv = RET_HEADS * RET_DK, RET_HEADS * RET_DV
    q, k, v, g = jnp.split(h @ w_in, [hk, 2 * hk, 2 * hk + hv], axis=-1)
    q = q.reshape(B, S, RET_HEADS, RET_DK).astype(f32)
    k = k.reshape(B, S, RET_HEADS, RET_DK).astype(f32) * (RET_DK ** -0.5)
    v = v.reshape(B, S, RET_HEADS, RET_DV).astype(f32)
    log_gamma = -jnp.exp(log_rate.astype(f32))
    o_f, s_f = retention_scan(q, k, v, log_gamma[0], s0_fwd.astype(f32))
    o_b, s_b = retention_scan(q[:, ::-1], k[:, ::-1], v[:, ::-1], log_gamma[1], s0_bwd.astype(f32))
    o = o_f + o_b[:, ::-1]
    mu = jnp.mean(o, axis=-1, keepdims=True)
    var = jnp.mean(jnp.square(o - mu), axis=-1, keepdims=True)
    o = ((o - mu) * lax.rsqrt(var + EPS)).reshape(B, S, hv) * gn_g.astype(f32)
    y = jax.nn.silu(g) * o.astype(h.dtype)
    return y @ w_out, s_f.astype(h.dtype), s_b.astype(h.dtype)


def swiglu(h, w_in, w_out):
    a, b = jnp.split(h @ w_in, 2, axis=-1)
    return (jax.nn.silu(a) * b) @ w_out


def setup_inputs(seed: int = 0) -> dict:
    key = jax.random.key(seed)
    ks = jax.random.split(key, 32)
    f32 = jnp.float32

    def nrm(k, shape, scale):
        return jax.random.normal(k, shape, f32) * scale

    def gain(k, shape):
        return 1.0 + 0.05 * jax.random.normal(k, shape, f32)

    D = D_MODEL
    hk, hv = RET_HEADS * RET_DK, RET_HEADS * RET_DV
    base_rate = jnp.log(-jnp.log1p(-(2.0 ** (-5.0 - jnp.arange(RET_HEADS, dtype=f32)))))
    ret_log_rate = base_rate[None, None, :] + 0.1 * jax.random.normal(ks[25], (N_RET, 2, RET_HEADS), f32)
    return {
        'x_prompt': nrm(ks[0], (BATCH, SEQ, D), 1.0),
        'x_sample': nrm(ks[1], (DEC_BATCH, DEC_SEQ, D), 1.0),
        'c': nrm(ks[2], (DEC_BATCH, D), 1.0),
        'c_ctx': nrm(ks[3], (D,), 1.0),
        'cache_mla_ckv': nrm(ks[4], (DEC_BATCH, N_MLA, PAST_LEN, MLA_KV_RANK), 1.0),
        'cache_mla_kpe': nrm(ks[5], (DEC_BATCH, N_MLA, PAST_LEN, MLA_ROPE), 1.0),
        'state_ret': nrm(ks[6], (DEC_BATCH, N_RET, 2, RET_HEADS, RET_DK, RET_DV), 0.5),
        'ada_w': nrm(ks[7], (DEPTH, D, 6 * D), 0.5 * D ** -0.5),
        'ada_b': nrm(ks[8], (DEPTH, 6 * D), 0.02),
        'norm_mix_g': gain(ks[9], (DEPTH, D)),
        'norm_ffn_g': gain(ks[10], (DEPTH, D)),
        'mla_w_a': nrm(ks[11], (N_MLA, D, MLA_Q_RANK + MLA_KV_RANK + MLA_ROPE), D ** -0.5),
        'mla_q_norm_g': gain(ks[12], (N_MLA, MLA_Q_RANK)),
        'mla_kv_norm_g': gain(ks[13], (N_MLA, MLA_KV_RANK)),
        'mla_w_q_b': nrm(ks[14], (N_MLA, MLA_Q_RANK, MLA_HEADS * (MLA_NOPE + MLA_ROPE)), MLA_Q_RANK ** -0.5),
        'mla_w_kv_b': nrm(ks[15], (N_MLA, MLA_KV_RANK, MLA_HEADS * (MLA_NOPE + MLA_V)), MLA_KV_RANK ** -0.5),
        'mla_w_o': nrm(ks[16], (N_MLA, MLA_HEADS * MLA_V, D), (MLA_HEADS * MLA_V) ** -0.5),
        'conv_w_in': nrm(ks[17], (N_CONV, D, 3 * D), D ** -0.5),
        'conv_w': nrm(ks[18], (N_CONV, CONV_WIDTH, D), CONV_WIDTH ** -0.5),
        'conv_w_out': nrm(ks[19], (N_CONV, D, D), D ** -0.5),
        'ret_w_in': nrm(ks[20], (N_RET, D, 2 * hk + 2 * hv), D ** -0.5),
        'ret_log_rate': ret_log_rate,
        'ret_gn_g': gain(ks[21], (N_RET, hv)),
        'ret_w_out': nrm(ks[22], (N_RET, hv, D), hv ** -0.5),
        'ffn_w_in': nrm(ks[23], (DEPTH, D, 2 * FFN_HIDDEN), D ** -0.5),
        'ffn_w_out': nrm(ks[24], (DEPTH, FFN_HIDDEN, D), FFN_HIDDEN ** -0.5),
        'final_norm_g': gain(ks[26], (D,)),
    }


def reference(x_prompt, x_sample, c, c_ctx, cache_mla_ckv, cache_mla_kpe, state_ret,
              ada_w, ada_b, norm_mix_g, norm_ffn_g,
              mla_w_a, mla_q_norm_g, mla_kv_norm_g, mla_w_q_b, mla_w_kv_b, mla_w_o,
              conv_w_in, conv_w, conv_w_out,
              ret_w_in, ret_log_rate, ret_gn_g, ret_w_out,
              ffn_w_in, ffn_w_out, final_norm_g):
    cos, sin = axial_rope_tables(x_sample.shape[1])
    xc, xs = x_prompt, x_sample
    new_ckv, new_kpe, new_ret = [], [], []
    for i in range(DEPTH):
        kind, j = i % N_MIXERS, i // N_MIXERS
        mod_c = jnp.split((jax.nn.silu(c_ctx) @ ada_w[i] + ada_b[i])[None, None, :], 6, axis=-1)
        mod_s = jnp.split((jax.nn.silu(c) @ ada_w[i] + ada_b[i])[:, None, :], 6, axis=-1)
        hc = modulate(xc, norm_mix_g[i], mod_c[0], mod_c[1])
        hs = modulate(xs, norm_mix_g[i], mod_s[0], mod_s[1])
        if kind == 0:
            qn, qp, ckv, kpe = mla_project(hc, mla_w_a[j], mla_q_norm_g[j], mla_kv_norm_g[j], mla_w_q_b[j])
            kn, vv = mla_expand(ckv, mla_w_kv_b[j])
            oc = mla_attend(qn, qp, kn, kpe, vv, mla_w_o[j])
            new_ckv.append(ckv)
            new_kpe.append(kpe)
            qn_s, qp_s, ckv_s, kpe_s = mla_project(hs, mla_w_a[j], mla_q_norm_g[j], mla_kv_norm_g[j], mla_w_q_b[j])
            qp_s = apply_axial_rope(qp_s, cos[:, None], sin[:, None])
            kpe_s = apply_axial_rope(kpe_s, cos, sin)
            kn_s, v_s = mla_expand(ckv_s, mla_w_kv_b[j])
            kn_p, v_p = mla_expand(cache_mla_ckv[:, j], mla_w_kv_b[j])
            os_ = mla_attend(qn_s, qp_s,
                             jnp.concatenate([kn_p, kn_s], axis=1),
                             jnp.concatenate([cache_mla_kpe[:, j], kpe_s], axis=1),
                             jnp.concatenate([v_p, v_s], axis=1), mla_w_o[j])
        elif kind == 1:
            oc = short_conv_mixer(hc, conv_w_in[j], conv_w[j], conv_w_out[j])
            os_ = short_conv_mixer(hs, conv_w_in[j], conv_w[j], conv_w_out[j])
        else:
            zeros = jnp.zeros((xc.shape[0], RET_HEADS, RET_DK, RET_DV), xc.dtype)
            oc, s_f, s_b = retention_mixer(hc, ret_w_in[j], ret_log_rate[j], ret_gn_g[j], ret_w_out[j], zeros, zeros)
            new_ret.append(jnp.stack([s_f, s_b], axis=1))
            os_, _, _ = retention_mixer(hs, ret_w_in[j], ret_log_rate[j], ret_gn_g[j], ret_w_out[j],
                                        state_ret[:, j, 0], state_ret[:, j, 1])
        xc = xc + mod_c[2] * oc
        xs = xs + mod_s[2] * os_
        hc = modulate(xc, norm_ffn_g[i], mod_c[3], mod_c[4])
        hs = modulate(xs, norm_ffn_g[i], mod_s[3], mod_s[4])
        xc = xc + mod_c[5] * swiglu(hc, ffn_w_in[i], ffn_w_out[i])
        xs = xs + mod_s[5] * swiglu(hs, ffn_w_in[i], ffn_w_out[i])
    y_prompt = rmsnorm(xc, final_norm_g)
    y_sample = rmsnorm(xs, final_norm_g)
    return (y_prompt, y_sample, jnp.stack(new_ckv, axis=1), jnp.stack(new_kpe, axis=1), jnp.stack(new_ret, axis=1))
```

```cpp
#include <hip/hip_runtime.h>
#include <hip/hip_cooperative_groups.h>
#include <cstdio>
#include <cstring>
namespace cg = cooperative_groups;

typedef unsigned short bf16_t;
typedef short bf16x8 __attribute__((ext_vector_type(8)));
typedef float f32x16 __attribute__((ext_vector_type(16)));
typedef __bf16 bf2_t __attribute__((ext_vector_type(2)));
typedef float f2_t __attribute__((ext_vector_type(2)));
typedef unsigned u32x4 __attribute__((ext_vector_type(4)));
typedef unsigned u32x2 __attribute__((ext_vector_type(2)));
typedef float f32x4 __attribute__((ext_vector_type(4)));
typedef float f32x2 __attribute__((ext_vector_type(2)));

#define DI __device__ __forceinline__
#define MK4(a, b, c, d) ((u32x4){(a), (b), (c), (d)})
#define MK2(a, b) ((u32x2){(a), (b)})
#define MKF4(a, b, c, d) ((f32x4){(a), (b), (c), (d)})
#define MKF2(a, b) ((f32x2){(a), (b)})
#define MFMA(a, b, c) __builtin_amdgcn_mfma_f32_32x32x16_bf16((a), (b), (c), 0, 0, 0)

static constexpr int T_TOK = 16384;
static constexpr int TCTX = 8192;
static constexpr int KVROWS = 18432;
static constexpr float LOG2E = 1.4426950408889634f;

DI unsigned pk(float a, float b) { f2_t v = {a, b}; bf2_t r = __builtin_convertvector(v, bf2_t); return __builtin_bit_cast(unsigned, r); }
DI bf16_t bf1(float a) { return (bf16_t)(pk(a, 0.f) & 0xffffu); }
DI u32x2 pack4(float a, float b, float c, float d) { return MK2(pk(a, b), pk(c, d)); }
DI float bflo(unsigned u) { return __uint_as_float(u << 16); }
DI float bfhi(unsigned u) { return __uint_as_float(u & 0xffff0000u); }
DI int crow(int reg, int h) { return (reg & 3) + 8 * (reg >> 2) + 4 * h; }
DI float silu_f(float x) { return x * __builtin_amdgcn_rcpf(1.f + __builtin_amdgcn_exp2f(-1.4426950408889634f * x)); }
DI float ex2(float x) { return __builtin_amdgcn_exp2f(x); }
DI bf16x8 mk8(u32x2 lo, u32x2 hi) { u32x4 v = {lo.x, lo.y, hi.x, hi.y}; return __builtin_bit_cast(bf16x8, v); }
DI bf16x8 mk8(u32x4 q) { return __builtin_bit_cast(bf16x8, q); }
#define PACK8(X, S) mk8(MK4(pk((X)[8 * (S)], (X)[8 * (S) + 1]), pk((X)[8 * (S) + 2], (X)[8 * (S) + 3]), pk((X)[8 * (S) + 4], (X)[8 * (S) + 5]), pk((X)[8 * (S) + 6], (X)[8 * (S) + 7])))
DI int opaque(int v) { asm volatile("" : "+v"(v)); return v; }
DI float opaquef(float v) { asm volatile("" : "+v"(v)); return v; }
DI float shx(float v, int mask, int lane) { return __int_as_float(__builtin_amdgcn_ds_bpermute((lane ^ mask) << 2, __float_as_int(v))); }
DI int opqs(int v) { asm volatile("" : "+s"(v)); return v; }
DI int opq0() { int z = 0; asm volatile("" : "+s"(z)); return z; }
template <typename T> DI T* opqp(T* p) {
  unsigned long long v = (unsigned long long)p;
  unsigned lo = (unsigned)v, hi = (unsigned)(v >> 32);
  asm volatile("" : "+v"(lo), "+v"(hi));
  lo = __builtin_amdgcn_readfirstlane(lo); hi = __builtin_amdgcn_readfirstlane(hi);
  v = ((unsigned long long)hi << 32) | lo;
  return (T*)(__attribute__((address_space(1))) T*)v;
}
DI int cond_row(int t) { return t < TCTX ? 4 : ((t - TCTX) >> 11); }

__constant__ double c_invf[16] = {1.0, 0.5623413251903491, 0.31622776601683794, 0.1778279410038923, 0.1, 0.05623413251903491, 0.03162277660168379,
                                 0.01778279410038923, 0.01, 0.005623413251903491, 0.0031622776601683794, 0.0017782794100389228, 0.001,
                                 0.0005623413251903491, 0.00031622776601683794, 0.00017782794100389227};
struct ConvDesc { const float* src; bf16_t* dst; int K, N, Npad, mode, tile0, pad; };
static constexpr int NDESC = 20;

struct Params {
  const float* in[27];
  float* out;
  char* ws;
  ConvDesc cd[NDESC];
  int conv_tiles;
  int conv_tiles_early;
  int nph;
  int dup;
  int pad2;
};

static constexpr size_t OFF_MOD = 0;
static constexpr size_t OFF_CS = 524288;
static constexpr size_t OFF_WT = 1048576;
static constexpr size_t OFF_H = OFF_WT + 53084160ull * 2;
static constexpr size_t OFF_SCR = OFF_H + 33554432ull;
static constexpr size_t S_A = 0;
static constexpr size_t S_QAN = 50331648;
static constexpr size_t S_CKVN = 62914560;
static constexpr size_t S_KPEB = 72351744;
static constexpr size_t S_Q = 74711040;
static constexpr size_t S_KNOPE = 125042688;
static constexpr size_t S_VT = 162791424;
static constexpr size_t S_BB = 0, S_Z = 33554432, S_BZ = 67108864;
static constexpr size_t S_SGY = 0;
static constexpr size_t S_RQ = 67108864;
static constexpr size_t S_RK = 83886080;
static constexpr size_t S_RKT = 100663296;
static constexpr size_t S_RVT = 117440512;
static constexpr size_t S_CRF = 150994944;
static constexpr size_t S_CRB = 184549376;
static constexpr size_t SCR_BYTES = 218103808;
static constexpr size_t S_HID = 0;
static constexpr size_t OFF_BAR = OFF_SCR + SCR_BYTES;
static constexpr size_t OFF_RSS = OFF_BAR + 16384;
static constexpr size_t WS_NEED = OFF_RSS + 8 * 65536;
static constexpr int CNT_WORD0 = 3520;

static constexpr size_t OUT_CKV = 16777216, OUT_KPE = 20971520, OUT_STATE = 22020096;

static constexpr int SMEM_BYTES = 147456;
static constexpr int HALF_LDS = 73728;

DI void convert_tile(const Params& p, char* smem, int item, int tid) {
  int di = 0;
#pragma unroll 1
  for (int i = 1; i < NDESC; ++i) if (item >= p.cd[i].tile0) di = i;
  const ConvDesc d = p.cd[di];
  const int lt = item - d.tile0, ktiles = d.K >> 6;
  const int nt = lt / ktiles, kt = lt - nt * ktiles;
  const int n0 = nt * 64, k0 = kt * 64;
  float* tile = (float*)smem;
  {
    const int tx = tid & 63, ty = tid >> 6;
    const int np = n0 + tx;
    int sc = np;
    if (d.mode == 1) { if (np >= 1024) { int q = np - 1024, grp = q >> 5, ww = q & 31; sc = 1024 + (ww >> 4) * 1024 + grp * 16 + (ww & 15); } }
    else if (d.mode == 2) { int grp = np >> 5, ww = np & 31; sc = (ww >> 4) * 2816 + grp * 16 + (ww & 15); }
    const bool valid = np < d.N;
#pragma unroll
    for (int rr = 0; rr < 8; ++rr) {
      const int k = ty * 8 + rr;
      tile[k * 65 + tx] = valid ? d.src[(size_t)(k0 + k) * d.N + sc] : 0.f;
    }
  }
  __syncthreads();
  {
    const int nl = tid >> 3, ks = (tid & 7) * 8;
    unsigned u[4];
#pragma unroll
    for (int i = 0; i < 4; ++i) u[i] = pk(tile[(ks + 2 * i) * 65 + nl], tile[(ks + 2 * i + 1) * 65 + nl]);
    *(u32x4*)(d.dst + (size_t)(n0 + nl) * d.K + k0 + ks) = MK4(u[0], u[1], u[2], u[3]);
  }
  __syncthreads();
}

DI void prep_phase(const Params& p, char* smem) {
  char* ws_ = opqp(p.ws); float* out_ = opqp(p.out);
  { float* rss = (float*)(ws_ + OFF_RSS); for (int i = blockIdx.x * 512 + (int)threadIdx.x; i < 8 * T_TOK; i += gridDim.x * 512) rss[i] = 0.f; }
  const int tid = opaque((int)threadIdx.x), lane = tid & 63, w = tid >> 6;
  const int n_conv = p.conv_tiles_early, n_ada = 192, n_cs = 128;
  const int total = n_conv + n_ada + n_cs;
  for (int item = blockIdx.x; item < total; item += gridDim.x) {
    if (item < n_conv) {
      convert_tile(p, smem, item, tid);
    } else if (item < n_conv + n_ada) {
      const int it = item - n_conv, layer = it / 48, cb = it % 48;
      float* ssil = (float*)smem;
      float* red = ssil + 5 * 1024;
      for (int i = tid; i < 5 * 1024; i += 512) {
        const int rr = i >> 10, k = i & 1023;
        const float v = rr < 4 ? p.in[opqs(2)][rr * 1024 + k] : p.in[opqs(3)][k];
        ssil[i] = silu_f(v);
      }
      __syncthreads();
      const float* W = p.in[opqs(7)] + (size_t)layer * 1024 * 6144 + cb * 128 + lane * 2;
      float acc[5][2];
#pragma unroll
      for (int rr = 0; rr < 5; ++rr) { acc[rr][0] = 0.f; acc[rr][1] = 0.f; }
#pragma unroll 4
      for (int kk = 0; kk < 128; ++kk) {
        const int k = w * 128 + kk;
        const f32x2 wv = *(const f32x2*)(W + (size_t)k * 6144);
#pragma unroll
        for (int rr = 0; rr < 5; ++rr) { const float s = ssil[rr * 1024 + k]; acc[rr][0] += s * wv.x; acc[rr][1] += s * wv.y; }
      }
#pragma unroll
      for (int rr = 0; rr < 5; ++rr) { red[(w * 5 + rr) * 128 + lane * 2] = acc[rr][0]; red[(w * 5 + rr) * 128 + lane * 2 + 1] = acc[rr][1]; }
      __syncthreads();
      float* mod = (float*)(ws_ + OFF_MOD);
      for (int i = tid; i < 640; i += 512) {
        const int rr = i >> 7, cn = i & 127;
        float s = p.in[opqs(8)][layer * 6144 + cb * 128 + cn];
#pragma unroll
        for (int ww = 0; ww < 8; ++ww) s += red[(ww * 5 + rr) * 128 + cn];
        mod[(size_t)(layer * 5 + rr) * 6144 + cb * 128 + cn] = s;
      }
      __syncthreads();
    } else {
      const int idx = (item - n_conv - n_ada) * 512 + tid;
      const int pos = idx >> 5, e = idx & 31, axis = e >> 4, f = e & 15;
      const double iv = c_invf[f];
      const float pf = (float)(axis == 0 ? (pos >> 6) : (pos & 63));
      const float angf = pf * (float)iv;
      const double ang = (double)angf;
      const double kq = rint(ang * 0.6366197723675814);
      const double rr = ang - kq * 1.5707963267948966;
      const double r2 = rr * rr;
      const double sn = rr * (1.0 + r2 * (-1.0 / 6 + r2 * (1.0 / 120 + r2 * (-1.0 / 5040 + r2 * (1.0 / 362880 + r2 * (-1.0 / 39916800 + r2 * (1.0 / 6227020800.0)))))));
      const double cn = 1.0 + r2 * (-0.5 + r2 * (1.0 / 24 + r2 * (-1.0 / 720 + r2 * (1.0 / 40320 + r2 * (-1.0 / 3628800 + r2 * (1.0 / 479001600.0))))));
      const int qd = ((int)kq) & 3;
      double c, s;
      if (qd == 0) { c = cn; s = sn; } else if (qd == 1) { c = -sn; s = cn; } else if (qd == 2) { c = -cn; s = -sn; } else { c = sn; s = -cn; }
      f32x2* cs = (f32x2*)(ws_ + OFF_CS);
      cs[idx] = MKF2((float)c, (float)s);
    }
  }
}

DI void norm_phase(const Params& p, int layer, int which  ) {
  char* ws_ = opqp(p.ws); float* out_ = opqp(p.out);
  const int tid = opaque((int)threadIdx.x), lane = tid & 63, w = tid >> 6;
  float* x = out_;
  bf16_t* h = (bf16_t*)(ws_ + OFF_H);
  const float* mod = (const float*)(ws_ + OFF_MOD);
  const bool first = (layer == 0 && which == 0);
  const float* g = which == 2 ? p.in[opqs(26)] : (which == 0 ? p.in[opqs(9)] + layer * 1024 : p.in[opqs(10)] + layer * 1024);
  for (int t = blockIdx.x * 8 + w; t < T_TOK; t += gridDim.x * 8) {
    const float* src = first ? (t < TCTX ? p.in[opqs(0)] + (size_t)t * 1024 : p.in[opqs(1)] + (size_t)(t - TCTX) * 1024) : x + (size_t)t * 1024;
    f32x4 v[4];
    float ss = 0.f;
#pragma unroll
    for (int q = 0; q < 4; ++q) { v[q] = *(const f32x4*)(src + q * 256 + lane * 4); ss += v[q].x * v[q].x + v[q].y * v[q].y + v[q].z * v[q].z + v[q].w * v[q].w; }
#pragma unroll
    for (int o = 32; o >= 1; o >>= 1) ss += shx(ss, o, lane);
    const float rstd = rsqrtf(ss * (1.f / 1024.f) + 1e-6f);
    if (which == 2) {
#pragma unroll
      for (int q = 0; q < 4; ++q) {
        const int col = q * 256 + lane * 4;
        const f32x4 gg = *(const f32x4*)(g + col);
        f32x4 y; y.x = v[q].x * rstd * gg.x; y.y = v[q].y * rstd * gg.y; y.z = v[q].z * rstd * gg.z; y.w = v[q].w * rstd * gg.w;
        *(f32x4*)(x + (size_t)t * 1024 + col) = y;
      }
    } else {
      const int cr = cond_row(t);
      const float* sh = mod + (size_t)(layer * 5 + cr) * 6144 + (which == 0 ? 0 : 3) * 1024;
      const float* sc = sh + 1024;
#pragma unroll
      for (int q = 0; q < 4; ++q) {
        const int col = q * 256 + lane * 4;
        const f32x4 gg = *(const f32x4*)(g + col), s4 = *(const f32x4*)(sc + col), h4 = *(const f32x4*)(sh + col);
        const float y0 = v[q].x * rstd * gg.x * (1.f + s4.x) + h4.x, y1 = v[q].y * rstd * gg.y * (1.f + s4.y) + h4.y;
        const float y2 = v[q].z * rstd * gg.z * (1.f + s4.z) + h4.z, y3 = v[q].w * rstd * gg.w * (1.f + s4.w) + h4.w;
        *(u32x2*)(h + (size_t)t * 1024 + col) = pack4(y0, y1, y2, y3);
        if (first) *(f32x4*)(x + (size_t)t * 1024 + col) = v[q];
      }
    }
  }
}

enum { EPI_F32 = 0, EPI_Q, EPI_KV, EPI_RESID, EPI_SWIGLU, EPI_CONV, EPI_RET, EPI_RESIDN };
struct EpiArgs { float* f0; bf16_t* b0; bf16_t* b1; bf16_t* b2; bf16_t* b3; bf16_t* b4; const float* c0; int i0;
                 const float* c1; const float* c2; float* f1; bf16_t* b5; unsigned* u0; };

template <int EPI>
DI void epilogue(const EpiArgs& ea, int m, int nb, int h5, f32x16& acc) {
  if (EPI == EPI_F32) {
#pragma unroll
    for (int g = 0; g < 4; ++g) *(f32x4*)(ea.f0 + (size_t)m * 768 + nb + 8 * g + 4 * h5) = MKF4(acc[4 * g], acc[4 * g + 1], acc[4 * g + 2], acc[4 * g + 3]);
  } else if (EPI == EPI_Q) {
    const int dd = nb % 192;
    if (dd >= 128 && m >= TCTX) {
      const int pos = (m - TCTX) & 2047, axis = (dd - 128) >> 5;
      const f32x2* cs = (const f32x2*)ea.c0 + pos * 32 + axis * 16;
#pragma unroll
      for (int i = 0; i < 8; ++i) {
        const int f = 8 * (i >> 2) + 4 * h5 + (i & 3);
        const f32x2 c = cs[f];
        const float x1 = acc[i], x2 = acc[i + 8];
        acc[i] = x1 * c.x - x2 * c.y;
        acc[i + 8] = x2 * c.x + x1 * c.y;
      }
    }
#pragma unroll
    for (int g = 0; g < 4; ++g) *(u32x2*)(ea.b0 + (size_t)m * 1536 + nb + 8 * g + 4 * h5) = pack4(acc[4 * g], acc[4 * g + 1], acc[4 * g + 2], acc[4 * g + 3]);
  } else if (EPI == EPI_KV) {
    const int hd = nb >> 8, dd = nb & 255;
    if (dd < 128) {
#pragma unroll
      for (int g = 0; g < 4; ++g) *(u32x2*)(ea.b0 + (size_t)m * 1024 + hd * 128 + dd + 8 * g + 4 * h5) = pack4(acc[4 * g], acc[4 * g + 1], acc[4 * g + 2], acc[4 * g + 3]);
    } else {
#pragma unroll
      for (int i = 0; i < 16; ++i) ea.b1[(size_t)(hd * 128 + dd - 128 + crow(i, h5)) * KVROWS + m] = bf1(acc[i]);
    }
  } else if (EPI == EPI_RESID) {
    const int cr = cond_row(m);
#pragma unroll
    for (int g = 0; g < 4; ++g) {
      const int n = nb + 8 * g + 4 * h5;
      f32x4 xv = *(f32x4*)(ea.f0 + (size_t)m * 1024 + n);
      const f32x4 gv = *(const f32x4*)(ea.c0 + (size_t)cr * 6144 + n);
      xv.x += gv.x * acc[4 * g]; xv.y += gv.y * acc[4 * g + 1]; xv.z += gv.z * acc[4 * g + 2]; xv.w += gv.w * acc[4 * g + 3];
      *(f32x4*)(ea.f0 + (size_t)m * 1024 + n) = xv;
    }
  } else if (EPI == EPI_SWIGLU) {
    const int chb = (nb >> 5) * 16;
#pragma unroll
    for (int g = 0; g < 2; ++g)
      *(u32x2*)(ea.b0 + (size_t)m * 2816 + chb + 8 * g + 4 * h5) =
          pack4(silu_f(acc[4 * g]) * acc[4 * g + 8], silu_f(acc[4 * g + 1]) * acc[4 * g + 9], silu_f(acc[4 * g + 2]) * acc[4 * g + 10], silu_f(acc[4 * g + 3]) * acc[4 * g + 11]);
  } else if (EPI == EPI_CONV) {
    if (nb < 1024) {
#pragma unroll
      for (int g = 0; g < 4; ++g) *(u32x2*)(ea.b0 + (size_t)m * 1024 + nb + 8 * g + 4 * h5) = pack4(acc[4 * g], acc[4 * g + 1], acc[4 * g + 2], acc[4 * g + 3]);
    } else {
      const int chb = ((nb - 1024) >> 5) * 16;
#pragma unroll
      for (int g = 0; g < 2; ++g)
        *(u32x2*)(ea.b1 + (size_t)m * 1024 + chb + 8 * g + 4 * h5) =
            pack4(acc[4 * g] * acc[4 * g + 8], acc[4 * g + 1] * acc[4 * g + 9], acc[4 * g + 2] * acc[4 * g + 10], acc[4 * g + 3] * acc[4 * g + 11]);
    }
  } else if (EPI == EPI_RET) {
    if (nb < 1024) {
#pragma unroll
      for (int g = 0; g < 4; ++g) *(u32x2*)(ea.b0 + (size_t)m * 1024 + nb + 8 * g + 4 * h5) = pack4(acc[4 * g], acc[4 * g + 1], acc[4 * g + 2], acc[4 * g + 3]);
    } else if (nb < 2048) {
      const int c0 = nb - 1024;
#pragma unroll
      for (int i = 0; i < 16; ++i) acc[i] *= 0.0625f;
#pragma unroll
      for (int g = 0; g < 4; ++g) *(u32x2*)(ea.b1 + (size_t)m * 1024 + c0 + 8 * g + 4 * h5) = pack4(acc[4 * g], acc[4 * g + 1], acc[4 * g + 2], acc[4 * g + 3]);
#pragma unroll
      for (int i = 0; i < 16; ++i) ea.b2[(size_t)(c0 + crow(i, h5)) * 8192 + m] = bf1(acc[i]);
    } else if (nb < 4096) {
      const int c0 = nb - 2048;
#pragma unroll
      for (int i = 0; i < 16; ++i) ea.b3[(size_t)(c0 + crow(i, h5)) * 8192 + m] = bf1(acc[i]);
    } else {
      const int c0 = nb - 4096;
#pragma unroll
      for (int g = 0; g < 4; ++g)
        *(u32x2*)(ea.b4 + (size_t)(m + ea.i0) * 2048 + c0 + 8 * g + 4 * h5) = pack4(silu_f(acc[4 * g]), silu_f(acc[4 * g + 1]), silu_f(acc[4 * g + 2]), silu_f(acc[4 * g + 3]));
    }
  }
}

template <int EPI>
DI void gemm_phase(const bf16_t* A, int lda, const bf16_t* Bt, int K, int M, int N, const EpiArgs ea_in, char* smem) {
  const int tid = opaque((int)threadIdx.x), lane = tid & 63, w = tid >> 6, wm = w >> 2, wn = w & 3, r = lane & 31, h5 = lane >> 5;
  constexpr int BUF = 73728, AOFF = 0, BOFF = 36864;
  A = opqp(A); Bt = opqp(Bt);
  EpiArgs ea = ea_in;
  ea.f0 = opqp(ea.f0); ea.b0 = opqp(ea.b0); ea.b1 = opqp(ea.b1); ea.b2 = opqp(ea.b2); ea.b3 = opqp(ea.b3); ea.b4 = opqp(ea.b4); ea.c0 = opqp(ea.c0);
  if (EPI == EPI_RESIDN) { ea.c1 = opqp(ea.c1); ea.c2 = opqp(ea.c2); ea.f1 = opqp(ea.f1); ea.b5 = opqp(ea.b5); ea.u0 = opqp(ea.u0); }
  const int MT = M >> 8, NT = N >> 8, ntiles = MT * NT, KT = K >> 6;
  const int gfull = 32 * NT;
  const int lrow = tid >> 3, lkc = tid & 7;
  for (int id = blockIdx.x; id < ntiles; id += gridDim.x) {
    const int g = id / gfull, within = id - g * gfull;
    const int mrem = MT - g * 32, gm = mrem < 32 ? mrem : 32;
    const int mt = g * 32 + within % gm, nt = within / gm;
    const int m0 = mt << 8, n0 = nt << 8;
    f32x16 acc[4][2];
#pragma unroll
    for (int a = 0; a < 4; ++a)
#pragma unroll
      for (int b = 0; b < 2; ++b)
#pragma unroll
        for (int i = 0; i < 16; ++i) acc[a][b][i] = 0.f;
    u32x4 ra[4], rb[4];
    const char* Ab = (const char*)(A + (size_t)m0 * lda);
    const char* Bb = (const char*)(Bt + (size_t)n0 * K);
    const unsigned voa = (unsigned)(lrow * lda + lkc * 8) * 2u, vob = (unsigned)(lrow * K + lkc * 8) * 2u;
#define G_LOADP(s, k0) do { const char* as_ = Ab + ((size_t)(64 * (s)) * lda + (k0)) * 2; const char* bs_ = Bb + ((size_t)(64 * (s)) * K + (k0)) * 2; \
      ra[s] = *(const u32x4*)(as_ + voa); rb[s] = *(const u32x4*)(bs_ + vob); } while (0)
#define G_STOREP(s, buf) do { char* sb_ = smem + (buf) * BUF + lrow * 144 + lkc * 16 + (s) * 64 * 144; \
      *(u32x4*)(sb_ + AOFF) = ra[s]; *(u32x4*)(sb_ + BOFF) = rb[s]; } while (0)
#define G_ITER(buf, kt_) do { \
      const char* sa = smem + (buf) * BUF + AOFF + (128 * wm + r) * 144 + h5 * 16; \
      const char* sb = smem + (buf) * BUF + BOFF + (64 * wn + r) * 144 + h5 * 16; \
      _Pragma("unroll") for (int s = 0; s < 4; ++s) { \
        bf16x8 af[4], bfr[2]; \
        _Pragma("unroll") for (int a = 0; a < 4; ++a) af[a] = *(const bf16x8*)(sa + a * 32 * 144 + s * 32); \
        _Pragma("unroll") for (int b = 0; b < 2; ++b) bfr[b] = *(const bf16x8*)(sb + b * 32 * 144 + s * 32); \
        if ((kt_) + 1 < KT) G_STOREP(s, (buf) ^ 1); \
        if ((kt_) + 2 < KT) G_LOADP(s, ((kt_) + 2) << 6); \
        __builtin_amdgcn_sched_barrier(0); \
        _Pragma("unroll") for (int a = 0; a < 4; ++a) \
          _Pragma("unroll") for (int b = 0; b < 2; ++b) acc[a][b] = MFMA(bfr[b], af[a], acc[a][b]); \
        __builtin_amdgcn_sched_barrier(0); \
      } } while (0)
#pragma unroll
    for (int s = 0; s < 4; ++s) G_LOADP(s, 0);
#pragma unroll
    for (int s = 0; s < 4; ++s) G_STOREP(s, 0);
#pragma unroll
    for (int s = 0; s < 4; ++s) G_LOADP(s, 64);
    __syncthreads();
    for (int kt = 0; kt < KT; kt += 2) {
      G_ITER(0, kt);
      __syncthreads();
      G_ITER(1, kt + 1);
      __syncthreads();
    }
#undef G_ITER
#undef G_LOADP
#undef G_STOREP
    if (EPI == EPI_SWIGLU) {
#pragma unroll
      for (int a = 0; a < 4; ++a)
#pragma unroll
        for (int b = 0; b < 2; ++b)
#pragma unroll
          for (int g = 0; g < 2; ++g) {
            const f32x16& c = acc[a][b];
            *(u32x2*)(smem + (128 * wm + 32 * a + r) * 272 + (32 * wn + 16 * b + 8 * g + 4 * h5) * 2) =
                pack4(silu_f(c[4 * g]) * c[4 * g + 8], silu_f(c[4 * g + 1]) * c[4 * g + 9], silu_f(c[4 * g + 2]) * c[4 * g + 10], silu_f(c[4 * g + 3]) * c[4 * g + 11]);
          }
      __syncthreads();
      {
        bf16_t* outp = ea.b0 + (size_t)m0 * 2816 + (n0 >> 1);
#pragma unroll
        for (int ps = 0; ps < 8; ++ps) {
          const int c = tid + 512 * ps, row = c >> 4, part = c & 15;
          *(u32x4*)(outp + (size_t)row * 2816 + part * 8) = *(const u32x4*)(smem + row * 272 + part * 16);
        }
      }
      __syncthreads();
    } else if (EPI == EPI_RESIDN) {
#pragma unroll
      for (int a = 0; a < 4; ++a) {
        const int m = m0 + 128 * wm + 32 * a + r;
        const int cr = cond_row(m);
        float ss = 0.f;
#pragma unroll
        for (int b = 0; b < 2; ++b) {
          f32x4 xin[4], gin[4];
#pragma unroll
          for (int g = 0; g < 4; ++g) {
            const int n = n0 + 64 * wn + 32 * b + 8 * g + 4 * h5;
            xin[g] = *(const f32x4*)(ea.f0 + (size_t)m * 1024 + n);
            gin[g] = *(const f32x4*)(ea.c0 + (size_t)cr * 6144 + n);
          }
#pragma unroll
          for (int g = 0; g < 4; ++g) {
            const int n = n0 + 64 * wn + 32 * b + 8 * g + 4 * h5;
            f32x4 xv = xin[g];
            const f32x4 gv = gin[g];
            xv.x += gv.x * acc[a][b][4 * g]; xv.y += gv.y * acc[a][b][4 * g + 1]; xv.z += gv.z * acc[a][b][4 * g + 2]; xv.w += gv.w * acc[a][b][4 * g + 3];
            if (ea.i0 == 0) *(f32x4*)(ea.f0 + (size_t)m * 1024 + n) = xv;
            acc[a][b][4 * g] = xv.x; acc[a][b][4 * g + 1] = xv.y; acc[a][b][4 * g + 2] = xv.z; acc[a][b][4 * g + 3] = xv.w;
            ss += xv.x * xv.x + xv.y * xv.y + xv.z * xv.z + xv.w * xv.w;
          }
        }
        ss += shx(ss, 32, lane);
        if (h5 == 0) { const float prev = atomicAdd(ea.f1 + m, ss); asm volatile("" :: "v"(prev)); }
        __builtin_amdgcn_sched_barrier(0);
      }
      asm volatile("s_waitcnt vmcnt(0)" ::: "memory");
      __syncthreads();
      if (tid == 0) {
        unsigned* c = ea.u0 + mt;
        __hip_atomic_fetch_add(c, 1u, __ATOMIC_RELAXED, __HIP_MEMORY_SCOPE_AGENT);
        unsigned spins = 0;
        while (__hip_atomic_load(c, __ATOMIC_RELAXED, __HIP_MEMORY_SCOPE_AGENT) < (unsigned)NT) { __builtin_amdgcn_s_sleep(1); if (++spins > (1u << 22)) break; }
      }
      asm volatile("" ::: "memory");
      __syncthreads();
#pragma unroll
      for (int a = 0; a < 4; ++a) {
        const int m = m0 + 128 * wm + 32 * a + r;
        const int cr = cond_row(m);
        const float rstd = rsqrtf(__hip_atomic_load(ea.f1 + m, __ATOMIC_RELAXED, __HIP_MEMORY_SCOPE_AGENT) * (1.f / 1024.f) + 1e-6f);
#pragma unroll
        for (int b = 0; b < 2; ++b)
#pragma unroll
          for (int g = 0; g < 4; ++g) {
            const int n = n0 + 64 * wn + 32 * b + 8 * g + 4 * h5;
            const f32x4 gn = *(const f32x4*)(ea.c1 + n);
            const float y0 = acc[a][b][4 * g] * rstd * gn.x, y1 = acc[a][b][4 * g + 1] * rstd * gn.y, y2 = acc[a][b][4 * g + 2] * rstd * gn.z, y3 = acc[a][b][4 * g + 3] * rstd * gn.w;
            if (ea.i0 == 0) {
              const f32x4 sh = *(const f32x4*)(ea.c2 + (size_t)cr * 6144 + n), sc = *(const f32x4*)(ea.c2 + 1024 + (size_t)cr * 6144 + n);
              *(u32x2*)(ea.b5 + (size_t)m * 1024 + n) = pack4(y0 * (1.f + sc.x) + sh.x, y1 * (1.f + sc.y) + sh.y, y2 * (1.f + sc.z) + sh.z, y3 * (1.f + sc.w) + sh.w);
            } else {
              *(f32x4*)(ea.f0 + (size_t)m * 1024 + n) = MKF4(y0, y1, y2, y3);
            }
          }
        __builtin_amdgcn_sched_barrier(0);
      }
    } else {
#pragma unroll
      for (int a = 0; a < 4; ++a)
#pragma unroll
        for (int b = 0; b < 2; ++b) { epilogue<EPI>(ea, m0 + 128 * wm + 32 * a + r, n0 + 64 * wn + 32 * b, h5, acc[a][b]); __builtin_amdgcn_sched_barrier(0); }
    }
  }
}

DI void mla_post_phase(const Params& p, int j) {
  char* ws_ = opqp(p.ws); float* out_ = opqp(p.out);
  const int tid = opaque((int)threadIdx.x), lane = tid & 63, w = tid >> 6;
  const float* a = (const float*)(ws_ + OFF_SCR + S_A);
  bf16_t* qan = (bf16_t*)(ws_ + OFF_SCR + S_QAN);
  bf16_t* ckvn = (bf16_t*)(ws_ + OFF_SCR + S_CKVN);
  bf16_t* kpeb = (bf16_t*)(ws_ + OFF_SCR + S_KPEB);
  const f32x2* cs = (const f32x2*)(ws_ + OFF_CS);
  const float* gq = p.in[opqs(12)] + j * 384;
  const float* gkv = p.in[opqs(13)] + j * 256;
  for (int rw = blockIdx.x * 8 + w; rw < KVROWS; rw += gridDim.x * 8) {
    int t = -1, pos = 0, cb = 0, cp = 0;
    if (rw < TCTX) t = rw;
    else {
      const int rr = rw - TCTX; cb = rr / 2560; const int pp = rr - cb * 2560;
      if (pp < 512) cp = pp; else { pos = pp - 512; t = TCTX + cb * 2048 + pos; }
    }
    if (t >= 0) {
      const float* ar = a + (size_t)t * 768;
      f32x2 qv[3]; float ss = 0.f;
#pragma unroll
      for (int q = 0; q < 3; ++q) { qv[q] = *(const f32x2*)(ar + q * 128 + lane * 2); ss += qv[q].x * qv[q].x + qv[q].y * qv[q].y; }
      const f32x4 cv = *(const f32x4*)(ar + 384 + lane * 4);
      float s2 = cv.x * cv.x + cv.y * cv.y + cv.z * cv.z + cv.w * cv.w;
      const float kv = ar[640 + lane];
#pragma unroll
      for (int o = 32; o >= 1; o >>= 1) { ss += shx(ss, o, lane); s2 += shx(s2, o, lane); }
      const float rq = rsqrtf(ss * (1.f / 384.f) + 1e-6f), rc = rsqrtf(s2 * (1.f / 256.f) + 1e-6f);
#pragma unroll
      for (int q = 0; q < 3; ++q) {
        const int col = q * 128 + lane * 2;
        *(unsigned*)(qan + (size_t)t * 384 + col) = pk(qv[q].x * rq * gq[col], qv[q].y * rq * gq[col + 1]);
      }
      const f32x4 g4 = *(const f32x4*)(gkv + lane * 4);
      const float c0 = cv.x * rc * g4.x, c1 = cv.y * rc * g4.y, c2 = cv.z * rc * g4.z, c3 = cv.w * rc * g4.w;
      *(u32x2*)(ckvn + (size_t)rw * 256 + lane * 4) = pack4(c0, c1, c2, c3);
      float ko = kv;
      if (t < TCTX) {
        const int b = t >> 8, s = t & 255;
        *(f32x4*)(out_ + OUT_CKV + ((size_t)(b * 2 + j) * 256 + s) * 256 + lane * 4) = MKF4(c0, c1, c2, c3);
        out_[OUT_KPE + ((size_t)(b * 2 + j) * 256 + s) * 64 + lane] = kv;
      } else {
        const float partner = shx(kv, 16, lane);
        const int axis = lane >> 5, half = (lane >> 4) & 1, f = lane & 15;
        const f32x2 c = cs[pos * 32 + axis * 16 + f];
        ko = half ? (kv * c.x + partner * c.y) : (kv * c.x - partner * c.y);
      }
      kpeb[(size_t)rw * 64 + lane] = bf1(ko);
    } else {
      const float* cr = p.in[opqs(4)] + ((size_t)(cb * 2 + j) * 512 + cp) * 256;
      const f32x4 cv = *(const f32x4*)(cr + lane * 4);
      *(u32x2*)(ckvn + (size_t)rw * 256 + lane * 4) = pack4(cv.x, cv.y, cv.z, cv.w);
      kpeb[(size_t)rw * 64 + lane] = bf1(p.in[opqs(5)][((size_t)(cb * 2 + j) * 512 + cp) * 64 + lane]);
    }
  }
}

DI void attn_phase(const Params& p, char* smem) {
  char* ws_ = opqp(p.ws); float* out_ = opqp(p.out);
  const int tid0 = opaque((int)threadIdx.x), tid = tid0 & 255, vb = blockIdx.x * 2 + (tid0 >> 8), vg = gridDim.x * 2, lane = tid & 63, w = tid >> 6, r = lane & 31, h5 = lane >> 5;
  smem += (tid0 >> 8) * HALF_LDS;
  const bf16_t* q = (const bf16_t*)(ws_ + OFF_SCR + S_Q);
  const bf16_t* knope = (const bf16_t*)(ws_ + OFF_SCR + S_KNOPE);
  const bf16_t* kpeb = (const bf16_t*)(ws_ + OFF_SCR + S_KPEB);
  const bf16_t* vT = (const bf16_t*)(ws_ + OFF_SCR + S_VT);
  bf16_t* o = (bf16_t*)(ws_ + OFF_SCR + S_A);
  char* sK = smem;
  char* sV = smem + 25600;
  const float scl = 0.07216878364870322f * LOG2E;
  for (int item = vb; item < 1024; item += vg) {
    int hd, qtok0, krow0, nk;
    if (item < 512) { const int b = item >> 7; hd = (item >> 4) & 7; const int qb = item & 15; qtok0 = TCTX + b * 2048 + qb * 128; krow0 = TCTX + b * 2560; nk = 2560; }
    else { const int it = item - 512; const int b = it >> 4; hd = (it >> 1) & 7; const int qb = it & 1; qtok0 = b * 256 + qb * 128; krow0 = b * 256; nk = 256; }
    bf16x8 qf[12];
    {
      const bf16_t* qp = q + (size_t)(qtok0 + 32 * w + r) * 1536 + hd * 192 + 8 * h5;
#pragma unroll
      for (int s = 0; s < 12; ++s) qf[s] = *(const bf16x8*)(qp + 16 * s);
    }
    f32x16 oacc[4];
#pragma unroll
    for (int d = 0; d < 4; ++d)
#pragma unroll
      for (int i = 0; i < 16; ++i) oacc[d][i] = 0.f;
    float m_run = -1e30f, l_run = 0.f;
    const int nkt = nk >> 6;
    u32x4 pkr[6], pvr[4];
#define ATT_LOAD(kt_) do { const int kr_ = krow0 + (kt_) * 64; const int tidl = opaque((int)threadIdx.x) & 255; \
      _Pragma("unroll") for (int qq = 0; qq < 6; ++qq) { \
        const int c = tidl + 256 * qq, row = c / 24, cc = c - row * 24; \
        const bf16_t* src_ = cc < 16 ? knope + (size_t)(kr_ + row) * 1024 + hd * 128 + cc * 8 : kpeb + (size_t)(kr_ + row) * 64 + (cc - 16) * 8; \
        pkr[qq] = *(const u32x4*)src_; } \
      _Pragma("unroll") for (int qq = 0; qq < 4; ++qq) { \
        const int c = tidl + 256 * qq, row = c >> 3, cc = c & 7; \
        pvr[qq] = *(const u32x4*)(vT + (size_t)(hd * 128 + row) * KVROWS + kr_ + cc * 8); } } while (0)
    ATT_LOAD(0);
    for (int kt = 0; kt < nkt; ++kt) {
      __syncthreads();
      {
        const int tidl = opaque((int)threadIdx.x) & 255;
#pragma unroll
        for (int qq = 0; qq < 6; ++qq) {
          const int c = tidl + 256 * qq, row = c / 24, cc = c - row * 24;
          *(u32x4*)(sK + row * 400 + cc * 16) = pkr[qq];
        }
#pragma unroll
        for (int qq = 0; qq < 4; ++qq) {
          const int c = tidl + 256 * qq, row = c >> 3, cc = c & 7;
          *(u32x2*)(sV + row * 136 + cc * 16) = MK2(pvr[qq].x, pvr[qq].y);
          *(u32x2*)(sV + row * 136 + cc * 16 + 8) = MK2(pvr[qq].z, pvr[qq].w);
        }
      }
      __syncthreads();
      if (kt + 1 < nkt) ATT_LOAD(kt + 1);
      __builtin_amdgcn_sched_barrier(0);
      f32x16 st[2];
#pragma unroll
      for (int kb = 0; kb < 2; ++kb)
#pragma unroll
        for (int i = 0; i < 16; ++i) st[kb][i] = 0.f;
      {
        const char* kbase = sK + r * 400 + (8 * h5) * 2;
        bf16x8 kr[4];
#define QK_READ(i) kr[(i) & 3] = *(const bf16x8*)(kbase + (32 * ((i) / 12)) * 400 + (16 * ((i) % 12)) * 2)
        QK_READ(0); QK_READ(1); QK_READ(2);
        __builtin_amdgcn_sched_barrier(0);
#pragma unroll
        for (int i = 0; i < 24; ++i) {
          if (i + 3 < 24) QK_READ(i + 3);
          __builtin_amdgcn_sched_barrier(0);
          st[i / 12] = MFMA(kr[i & 3], qf[i % 12], st[i / 12]);
          __builtin_amdgcn_sched_barrier(0);
        }
#undef QK_READ
      }
      float mx = -1e30f;
#pragma unroll
      for (int kb = 0; kb < 2; ++kb)
#pragma unroll
        for (int i = 0; i < 16; ++i) { st[kb][i] *= scl; mx = fmaxf(mx, st[kb][i]); }
      mx = fmaxf(mx, shx(mx, 32, lane));
      const float mnew = fmaxf(m_run, mx);
      const float alpha = ex2(m_run - mnew);
      m_run = mnew;
      float psum = 0.f;
#pragma unroll
      for (int kb = 0; kb < 2; ++kb)
#pragma unroll
        for (int i = 0; i < 16; ++i) { const float pv = ex2(st[kb][i] - mnew); st[kb][i] = pv; psum += pv; }
      l_run = l_run * alpha + psum;
#pragma unroll
      for (int d = 0; d < 4; ++d)
#pragma unroll
        for (int i = 0; i < 16; ++i) oacc[d][i] *= alpha;
      {
        const char* vbase = sV + r * 136 + (4 * h5) * 2;
        u32x2 vlo[4], vhi[4];
#define PV_READ(j) do { const char* ap_ = vbase + (32 * ((j) & 3)) * 136 + (16 * ((j) >> 2)) * 2; vlo[(j) & 3] = *(const u32x2*)ap_; vhi[(j) & 3] = *(const u32x2*)(ap_ + 16); } while (0)
        PV_READ(0); PV_READ(1); PV_READ(2);
        bf16x8 bfr = PACK8(st[0], 0);
        __builtin_amdgcn_sched_barrier(0);
#pragma unroll
        for (int j = 0; j < 16; ++j) {
          if (j + 3 < 16) PV_READ(j + 3);
          if ((j & 3) == 0 && j > 0) bfr = PACK8(st[j >> 3], ((j >> 2) & 1));
          __builtin_amdgcn_sched_barrier(0);
          oacc[j & 3] = MFMA(mk8(vlo[j & 3], vhi[j & 3]), bfr, oacc[j & 3]);
          __builtin_amdgcn_sched_barrier(0);
        }
#undef PV_READ
      }
    }
    const float ltot = l_run + shx(l_run, 32, lane);
    const float inv = 1.f / ltot;
    bf16_t* op = o + (size_t)(qtok0 + 32 * w + r) * 1024 + hd * 128 + 4 * h5;
#pragma unroll
    for (int d = 0; d < 4; ++d)
#pragma unroll
      for (int g = 0; g < 4; ++g)
        *(u32x2*)(op + 32 * d + 8 * g) = pack4(oacc[d][4 * g] * inv, oacc[d][4 * g + 1] * inv, oacc[d][4 * g + 2] * inv, oacc[d][4 * g + 3] * inv);
  }
}

DI void conv_phase(const Params& p) {
  char* ws_ = opqp(p.ws); float* out_ = opqp(p.out);
  const bf16_t* bb = (const bf16_t*)(ws_ + OFF_SCR + S_BB);
  const bf16_t* z = (const bf16_t*)(ws_ + OFF_SCR + S_Z);
  bf16_t* bz = (bf16_t*)(ws_ + OFF_SCR + S_BZ);
  const float* cw = p.in[opqs(18)];
  const int tid = opaque((int)threadIdx.x);
  for (int idx = blockIdx.x * 512 + tid; idx < T_TOK * 128; idx += gridDim.x * 512) {
    const int t = idx >> 7, c8 = (idx & 127) * 8;
    const int L = t < TCTX ? 256 : 2048, pos = t & (L - 1);
    const u32x4 bv = *(const u32x4*)(bb + (size_t)t * 1024 + c8);
    const u32x4 z1 = *(const u32x4*)(z + (size_t)t * 1024 + c8);
    u32x4 z0 = MK4(0, 0, 0, 0), z2 = MK4(0, 0, 0, 0);
    if (pos != 0) z0 = *(const u32x4*)(z + (size_t)(t - 1) * 1024 + c8);
    if (pos != L - 1) z2 = *(const u32x4*)(z + (size_t)(t + 1) * 1024 + c8);
    const unsigned bu[4] = {bv.x, bv.y, bv.z, bv.w}, u0[4] = {z0.x, z0.y, z0.z, z0.w}, u1[4] = {z1.x, z1.y, z1.z, z1.w}, u2[4] = {z2.x, z2.y, z2.z, z2.w};
    const f32x4 wa0 = *(const f32x4*)(cw + c8), wa1 = *(const f32x4*)(cw + c8 + 4);
    const f32x4 wb0 = *(const f32x4*)(cw + 1024 + c8), wb1 = *(const f32x4*)(cw + 1024 + c8 + 4);
    const f32x4 wc0 = *(const f32x4*)(cw + 2048 + c8), wc1 = *(const f32x4*)(cw + 2048 + c8 + 4);
    const float w0[8] = {wa0.x, wa0.y, wa0.z, wa0.w, wa1.x, wa1.y, wa1.z, wa1.w};
    const float w1[8] = {wb0.x, wb0.y, wb0.z, wb0.w, wb1.x, wb1.y, wb1.z, wb1.w};
    const float w2[8] = {wc0.x, wc0.y, wc0.z, wc0.w, wc1.x, wc1.y, wc1.z, wc1.w};
    unsigned ou[4];
#pragma unroll
    for (int i = 0; i < 4; ++i) {
      const float lo = bflo(bu[i]) * (bflo(u0[i]) * w0[2 * i] + bflo(u1[i]) * w1[2 * i] + bflo(u2[i]) * w2[2 * i]);
      const float hi = bfhi(bu[i]) * (bfhi(u0[i]) * w0[2 * i + 1] + bfhi(u1[i]) * w1[2 * i + 1] + bfhi(u2[i]) * w2[2 * i + 1]);
      ou[i] = pk(lo, hi);
    }
    *(u32x4*)(bz + (size_t)t * 1024 + c8) = MK4(ou[0], ou[1], ou[2], ou[3]);
  }
}

template <int ROWS, int ROWB>
DI void stage_tile(const bf16_t* src, size_t rowstride, char* sm) {
  constexpr int CPR = ROWB / 16, NB = ROWS * CPR / 2048;
  const int tidv = opaque((int)threadIdx.x) & 255;
#pragma unroll
  for (int bq = 0; bq < NB; ++bq) {
    u32x4 v[8];
#pragma unroll
    for (int qq = 0; qq < 8; ++qq) {
      const int c = tidv + 256 * (bq * 8 + qq), row = c / CPR, kc = c % CPR;
      v[qq] = *(const u32x4*)(src + (size_t)row * rowstride + kc * 8);
    }
#pragma unroll
    for (int qq = 0; qq < 8; ++qq) {
      const int c = tidv + 256 * (bq * 8 + qq), row = c / CPR, kc = c % CPR;
      *(u32x2*)(sm + row * (ROWB + 8) + kc * 16) = MK2(v[qq].x, v[qq].y);
      *(u32x2*)(sm + row * (ROWB + 8) + kc * 16 + 8) = MK2(v[qq].z, v[qq].w);
    }
    __builtin_amdgcn_sched_barrier(0);
  }
}

DI void ret_scan_phase(const Params& p, int hf, char* smem) {
  char* ws_ = opqp(p.ws); float* out_ = opqp(p.out);
  const int tid0 = opaque((int)threadIdx.x), tid = tid0 & 255, vb = blockIdx.x * 2 + (tid0 >> 8), vg = gridDim.x * 2, lane = tid & 63, w = tid >> 6, r = lane & 31, h5 = lane >> 5;
  smem += (tid0 >> 8) * HALF_LDS;
  const int nseq = hf ? 4 : 32, seqlen = hf ? 2048 : 256, nchunks = seqlen >> 7;
  const int nitems = nseq * 32;
  const int spread = (nitems * 4 <= vg) ? 4 : 1;
  int item0 = vb, istep = vg;
  if (spread > 1) {
    const bool has = (vb % spread) == 0 && (vb / spread) < nitems;
    const int pvb = vb ^ 1;
    const bool phas = (pvb % spread) == 0 && (pvb / spread) < nitems;
    item0 = has ? vb / spread : nitems;
    istep = nitems;
    if (!has && phas) { for (int cs = 0; cs < nchunks; ++cs) { __syncthreads(); __syncthreads(); __syncthreads(); __syncthreads(); } }
    if (blockIdx.x & 1) {
      const int nb2 = gridDim.x >> 1;
      for (int it = p.conv_tiles_early + (int)(blockIdx.x >> 1); it < p.conv_tiles; it += nb2) convert_tile(p, smem - (tid0 >> 8) * HALF_LDS, it, tid0);
    }
  }
  for (int item = item0; item < nitems; item += istep) {
    const int es = item & 3, dir = (item >> 2) & 1, hd = (item >> 3) & 3, b = item >> 5;
    const float lg2 = -__expf(p.in[opqs(21)][dir * 4 + hd]) * LOG2E;
    const int tl0 = b * seqlen;
    const int ecol = hd * 512 + es * 128 + 32 * w + r;
    f32x16 S[8];
    if (hf) {
      const float* sp = p.in[opqs(6)] + ((size_t)((b * 2 + dir) * 4 + hd)) * 131072 + es * 128 + 32 * w + r;
#pragma unroll
      for (int db = 0; db < 8; ++db) {
        const float* spd = sp + (size_t)(opaque(4 * h5 * 512) + 32 * db * 512);
#pragma unroll
        for (int i = 0; i < 16; ++i) S[db][i] = spd[crow(i, 0) * 512];
        __builtin_amdgcn_sched_barrier(0);
      }
    } else {
#pragma unroll
      for (int db = 0; db < 8; ++db)
#pragma unroll
        for (int i = 0; i < 16; ++i) S[db][i] = 0.f;
    }
    const float cdecay = ex2(lg2 * 128.f);
#pragma unroll 1
    for (int cs = 0; cs < nchunks; ++cs) {
      const int c = dir ? nchunks - 1 - cs : cs;
      const int tc = tl0 + c * 128;
      const float cr_base = opaquef(lg2 * (dir ? (float)(128 - 4 * h5) : (float)(4 * h5 + 1)));
      const float cr_slope = opaquef(dir ? -lg2 : lg2);
      const float vw_base = opaquef(lg2 * (dir ? (float)(8 * h5) : (float)(127 - 8 * h5)));
      const float vw_slope = opaquef(dir ? lg2 : -lg2);
      const int ecolv = opaque(ecol);
      char* scrl = opqp(p.ws) + OFF_SCR;
      const bf16_t* rq = (const bf16_t*)(scrl + S_RQ);
      const bf16_t* rkT = (const bf16_t*)(scrl + S_RKT);
      const bf16_t* rvT = (const bf16_t*)(scrl + S_RVT);
      bf16_t* cross = (bf16_t*)(scrl + (dir ? S_CRB : S_CRF));
      __syncthreads();
      stage_tile<128, 512>(rq + (size_t)tc * 1024 + hd * 256, 1024, smem);
      __syncthreads();
      __builtin_amdgcn_sched_barrier(0);
#pragma unroll
      for (int ip = 0; ip < 4; ++ip) {
        f32x16 cacc;
#pragma unroll
        for (int i = 0; i < 16; ++i) cacc[i] = 0.f;
        {
          const char* qbase = smem + (32 * ip + r) * 520 + (4 * h5) * 2;
          u32x2 qlo[4], qhi[4];
#define CR_READ(i) do { const char* ap_ = qbase + (16 * (i)) * 2; qlo[(i) & 3] = *(const u32x2*)ap_; qhi[(i) & 3] = *(const u32x2*)(ap_ + 16); } while (0)
          CR_READ(0); CR_READ(1); CR_READ(2);
          __builtin_amdgcn_sched_barrier(0);
#pragma unroll
          for (int i = 0; i < 16; ++i) {
            if (i + 3 < 16) CR_READ(i + 3);
#pragma unroll
            for (int i8 = 0; i8 < 8; ++i8) { float t_ = S[i >> 1][8 * (i & 1) + i8]; asm volatile("" : "+v"(t_)); S[i >> 1][8 * (i & 1) + i8] = t_; }
            const bf16x8 bfr = PACK8(S[i >> 1], (i & 1));
            __builtin_amdgcn_sched_barrier(0);
            cacc = MFMA(mk8(qlo[i & 3], qhi[i & 3]), bfr, cacc);
            __builtin_amdgcn_sched_barrier(0);
          }
#undef CR_READ
        }
#pragma unroll
        for (int i = 0; i < 16; ++i) {
          const int ilc = 32 * ip + crow(i, 0);
          cross[(size_t)(tc + 4 * h5) * 2048 + ecolv + (size_t)ilc * 2048] = bf1(cacc[i] * ex2(__builtin_fmaf(cr_slope, (float)ilc, cr_base)));
        }
        __builtin_amdgcn_sched_barrier(0);
      }
      __syncthreads();
      stage_tile<256, 256>(rkT + (size_t)(hd * 256) * 8192 + tc, 8192, smem);
      __syncthreads();
      __builtin_amdgcn_sched_barrier(0);
#pragma unroll
      for (int db = 0; db < 8; ++db)
#pragma unroll
        for (int i = 0; i < 16; ++i) { float t_ = S[db][i]; asm volatile("v_mul_f32 %0, %0, %1" : "+v"(t_) : "v"(cdecay)); S[db][i] = t_; }
#pragma unroll
      for (int sh = 0; sh < 2; ++sh) {
        bf16x8 vf[4];
        {
          const bf16_t* vp = rvT + (size_t)ecolv * 8192 + tc + 8 * h5 + 64 * sh;
#pragma unroll
          for (int s = 0; s < 4; ++s) {
            const u32x4 raw = *(const u32x4*)(vp + 16 * s);
            const unsigned u[4] = {raw.x, raw.y, raw.z, raw.w};
            unsigned o4[4];
#pragma unroll
            for (int jj = 0; jj < 4; ++jj) {
              const int jc = 64 * sh + 16 * s + 2 * jj;
              o4[jj] = pk(bflo(u[jj]) * ex2(__builtin_fmaf(vw_slope, (float)jc, vw_base)), bfhi(u[jj]) * ex2(__builtin_fmaf(vw_slope, (float)(jc + 1), vw_base)));
            }
            vf[s] = mk8(MK4(o4[0], o4[1], o4[2], o4[3]));
          }
        }
        __builtin_amdgcn_sched_barrier(0);
        {
          const char* abase = smem + r * 264 + (64 * sh + 8 * h5) * 2;
          u32x2 rlo[4], rhi[4];
#define ST_READ(i) do { const char* ap_ = abase + (32 * ((i) >> 2)) * 264 + (16 * ((i) & 3)) * 2; rlo[(i) & 3] = *(const u32x2*)ap_; rhi[(i) & 3] = *(const u32x2*)(ap_ + 8); } while (0)
          ST_READ(0); ST_READ(1); ST_READ(2);
          __builtin_amdgcn_sched_barrier(0);
#pragma unroll
          for (int i = 0; i < 32; ++i) {
            if (i + 3 < 32) ST_READ(i + 3);
            __builtin_amdgcn_sched_barrier(0);
            S[i >> 2] = MFMA(mk8(rlo[i & 3], rhi[i & 3]), vf[i & 3], S[i >> 2]);
            __builtin_amdgcn_sched_barrier(0);
          }
#undef ST_READ
        }
      }
      __builtin_amdgcn_sched_barrier(0);
    }
    if (!hf) {
      float* so = out_ + OUT_STATE + ((size_t)((b * 2 + dir) * 4 + hd)) * 131072 + es * 128 + 32 * w + r;
#pragma unroll
      for (int db = 0; db < 8; ++db) {
        float* sod = so + (size_t)(opaque(4 * h5 * 512) + 32 * db * 512);
#pragma unroll
        for (int i = 0; i < 16; ++i) sod[crow(i, 0) * 512] = S[db][i];
        __builtin_amdgcn_sched_barrier(0);
      }
    }
  }
}

DI void ret_intra_phase(const Params& p, int hf, char* smem) {
  char* ws_ = opqp(p.ws); float* out_ = opqp(p.out);
  const int tid0 = opaque((int)threadIdx.x), tid = tid0 & 255, vb = blockIdx.x * 2 + (tid0 >> 8), vg = gridDim.x * 2, lane = tid & 63, w = tid >> 6, r = lane & 31, h5 = lane >> 5;
  smem += (tid0 >> 8) * HALF_LDS;
  const bf16_t* rq = (const bf16_t*)(ws_ + OFF_SCR + S_RQ);
  const bf16_t* rk = (const bf16_t*)(ws_ + OFF_SCR + S_RK);
  const bf16_t* rvT = (const bf16_t*)(ws_ + OFF_SCR + S_RVT);
  const bf16_t* crf = (const bf16_t*)(ws_ + OFF_SCR + S_CRF);
  const bf16_t* crb = (const bf16_t*)(ws_ + OFF_SCR + S_CRB);
  bf16_t* sgy = (bf16_t*)(ws_ + OFF_SCR + S_SGY) + (size_t)hf * 8192 * 2048;
  const float* gn = p.in[opqs(22)];
  u32x4* sP = (u32x4*)smem;
  f32x2* sStat = (f32x2*)(smem + 8192);
  for (int item = vb; item < 1024; item += vg) {
    const int hd = item & 3, tb = item >> 2, t0 = tb * 32, tc = t0 & ~127;
    const float lgf2 = -__expf(p.in[opqs(21)][hd]) * LOG2E, lgb2 = -__expf(p.in[opqs(21)][4 + hd]) * LOG2E;
    f32x16 pt;
#pragma unroll
    for (int i = 0; i < 16; ++i) pt[i] = 0.f;
    {
      const bf16_t* kp = rk + (size_t)(tc + 32 * w + r) * 1024 + hd * 256 + 8 * h5;
      const bf16_t* qp = rq + (size_t)(t0 + r) * 1024 + hd * 256 + 8 * h5;
#pragma unroll
      for (int bt = 0; bt < 2; ++bt) {
        bf16x8 kf[8], qv[8];
#pragma unroll
        for (int s = 0; s < 8; ++s) { kf[s] = *(const bf16x8*)(kp + 16 * (8 * bt + s)); qv[s] = *(const bf16x8*)(qp + 16 * (8 * bt + s)); }
        __builtin_amdgcn_sched_barrier(0);
#pragma unroll
        for (int s = 0; s < 8; ++s) pt = MFMA(kf[s], qv[s], pt);
        __builtin_amdgcn_sched_barrier(0);
      }
    }
    const int il = (t0 - tc) + r;
#pragma unroll
    for (int i = 0; i < 16; ++i) {
      const int j = 32 * w + crow(i, h5), diff = il - j;
      const float dec = diff > 0 ? ex2(lgf2 * (float)diff) : (diff < 0 ? ex2(lgb2 * (float)(-diff)) : 2.f);
      pt[i] *= dec;
    }
    __syncthreads();
    {
      const bf16x8 f0 = PACK8(pt, 0), f1 = PACK8(pt, 1);
      sP[(w * 2 + 0) * 64 + lane] = __builtin_bit_cast(u32x4, f0);
      sP[(w * 2 + 1) * 64 + lane] = __builtin_bit_cast(u32x4, f1);
    }
    __syncthreads();
    f32x16 o[4];
    {
      u32x4 bq[8];
#pragma unroll
      for (int q = 0; q < 8; ++q) bq[q] = sP[q * 64 + lane];
      u32x2 va[2][8], vb[2][8];
#define IV_LOAD(buf, eb_) do { const bf16_t* vrow_ = rvT + (size_t)(hd * 512 + 128 * w + 32 * (eb_) + r) * 8192 + tc + 4 * h5; \
        _Pragma("unroll") for (int q = 0; q < 8; ++q) { va[buf][q] = *(const u32x2*)(vrow_ + 16 * q); vb[buf][q] = *(const u32x2*)(vrow_ + 16 * q + 8); } } while (0)
      IV_LOAD(0, 0);
#pragma unroll
      for (int eb = 0; eb < 4; ++eb) {
        if (eb + 1 < 4) IV_LOAD((eb + 1) & 1, eb + 1);
        __builtin_amdgcn_sched_barrier(0);
#pragma unroll
        for (int i = 0; i < 16; ++i) o[eb][i] = 0.f;
#pragma unroll
        for (int q = 0; q < 8; ++q) o[eb] = MFMA(mk8(va[eb & 1][q], vb[eb & 1][q]), mk8(bq[q]), o[eb]);
        __builtin_amdgcn_sched_barrier(0);
      }
#undef IV_LOAD
    }
    const int t = t0 + r;
    float sum = 0.f, sq = 0.f;
    u32x2 cfv[16], cbv[16], sgv[16];
    {
      const size_t rowoff = (size_t)t * 2048 + hd * 512 + 128 * w + 4 * h5;
#pragma unroll
      for (int q = 0; q < 16; ++q) {
        cfv[q] = *(const u32x2*)(crf + rowoff + 8 * q);
        cbv[q] = *(const u32x2*)(crb + rowoff + 8 * q);
        sgv[q] = *(const u32x2*)(sgy + rowoff + 8 * q);
      }
    }
    __builtin_amdgcn_sched_barrier(0);
#pragma unroll
    for (int eb = 0; eb < 4; ++eb)
#pragma unroll
      for (int g = 0; g < 4; ++g) {
        const u32x2 cf = cfv[4 * eb + g], cb = cbv[4 * eb + g];
        o[eb][4 * g] += bflo(cf.x) + bflo(cb.x);
        o[eb][4 * g + 1] += bfhi(cf.x) + bfhi(cb.x);
        o[eb][4 * g + 2] += bflo(cf.y) + bflo(cb.y);
        o[eb][4 * g + 3] += bfhi(cf.y) + bfhi(cb.y);
#pragma unroll
        for (int jj = 0; jj < 4; ++jj) { const float v = o[eb][4 * g + jj]; sum += v; sq += v * v; }
      }
    f32x4 gnv[16];
#pragma unroll
    for (int q = 0; q < 16; ++q) gnv[q] = *(const f32x4*)(gn + hd * 512 + 128 * w + 4 * h5 + 8 * q);
    sum += shx(sum, 32, lane);
    sq += shx(sq, 32, lane);
    if (h5 == 0) sStat[w * 32 + r] = MKF2(sum, sq);
    __syncthreads();
    float ts = 0.f, tq = 0.f;
#pragma unroll
    for (int ww = 0; ww < 4; ++ww) { const f32x2 v = sStat[ww * 32 + r]; ts += v.x; tq += v.y; }
    const float mu = ts * (1.f / 512.f);
    const float var = fmaxf(tq * (1.f / 512.f) - mu * mu, 0.f);
    const float rstd = rsqrtf(var + 1e-6f);
#pragma unroll
    for (int eb = 0; eb < 4; ++eb)
#pragma unroll
      for (int g = 0; g < 4; ++g) {
        const int e = hd * 512 + 128 * w + 32 * eb + 8 * g + 4 * h5;
        bf16_t* yp = sgy + (size_t)t * 2048 + e;
        const u32x2 sg = sgv[4 * eb + g];
        const f32x4 gg = gnv[4 * eb + g];
        *(u32x2*)yp = pack4((o[eb][4 * g] - mu) * rstd * gg.x * bflo(sg.x), (o[eb][4 * g + 1] - mu) * rstd * gg.y * bfhi(sg.x),
                            (o[eb][4 * g + 2] - mu) * rstd * gg.z * bflo(sg.y), (o[eb][4 * g + 3] - mu) * rstd * gg.w * bfhi(sg.y));
      }
  }
}


#define XB_TMO      128
#define XB_XCNT(j)  (256  + 64 * (j))
#define XB_XSUB(j)  (1280 + 64 * (j))
#define XB_XGEN(j)  (2304 + 64 * (j))
#define XB_TOP      3328
#define XB_TOPGEN   3392
#define XCD_BAR_WORDS 3456
#define XB_SPIN_CAP (1u << 22)
#define LAS __attribute__((address_space(3)))
DI unsigned xb_ld(unsigned* p) { return __hip_atomic_load(p, __ATOMIC_RELAXED, __HIP_MEMORY_SCOPE_AGENT); }
DI unsigned xb_add(unsigned* p, unsigned v) { return __hip_atomic_fetch_add(p, v, __ATOMIC_RELAXED, __HIP_MEMORY_SCOPE_AGENT); }
DI unsigned xb_xcc_id() { return (unsigned)__builtin_amdgcn_s_getreg((3 << 11) | 20) & 0xFu; }
#define XB_SPIN(cond, bar) do { unsigned _sp = 0; while (cond) { __builtin_amdgcn_s_sleep(1); \
    if ((++_sp & 255u) == 0u) { if (xb_ld(&(bar)[XB_TMO])) break; if (_sp > XB_SPIN_CAP) { atomicAdd(&(bar)[XB_TMO], 1u); break; } } } } while (0)
DI void xcd_barrier_complete(unsigned* bar, unsigned x, unsigned& nloc, unsigned& nx) {
  const unsigned G = gridDim.x;
  unsigned sum, cnt, mine, sp = 0u;
  for (;;) {
    sum = 0u; cnt = 0u; mine = 0u;
#pragma unroll
    for (unsigned j = 0; j < 16; ++j) { const unsigned c = xb_ld(&bar[XB_XCNT(j)]); sum += c; cnt += (c > 0u) ? 1u : 0u; mine = (j == x) ? c : mine; }
    if (sum == G) break;
    __builtin_amdgcn_s_sleep(1);
    if ((++sp & 255u) == 0u) { if (xb_ld(&bar[XB_TMO])) break; if (sp > XB_SPIN_CAP) { atomicAdd(&bar[XB_TMO], 1u); break; } }
  }
  nloc = mine > 0u ? mine : 1u; nx = cnt > 0u ? cnt : 1u;
}
DI void xcd_barrier(unsigned* bar, volatile LAS unsigned* st) {
  asm volatile("s_waitcnt vmcnt(0)" ::: "memory");
  __syncthreads();
  if (threadIdx.x == 0) {
    const unsigned x = xb_xcc_id();
    __builtin_amdgcn_s_waitcnt(0);
    unsigned nloc = st[0], nx = st[1];
    if (nloc == 0u) { xcd_barrier_complete(bar, x, nloc, nx); st[0] = nloc; st[1] = nx; }
    const unsigned old = xb_add(&bar[XB_XSUB(x)], 1u);
    const unsigned gen = old / nloc;
    if (old + 1u == (gen + 1u) * nloc) {
      __builtin_amdgcn_fence(__ATOMIC_RELEASE, "agent");
      asm volatile("s_waitcnt vmcnt(0)" ::: "memory");
      const unsigned og = xb_add(&bar[XB_TOP], 1u);
      const unsigned tg = og / nx;
      if (og + 1u == (tg + 1u) * nx) xb_add(&bar[XB_TOPGEN], 1u);
      else XB_SPIN(xb_ld(&bar[XB_TOPGEN]) == tg, bar);
      __builtin_amdgcn_fence(__ATOMIC_ACQUIRE, "agent");
      xb_add(&bar[XB_XGEN(x)], 1u);
      asm volatile("s_waitcnt vmcnt(0)" ::: "memory");
    } else {
      XB_SPIN(xb_ld(&bar[XB_XGEN(x)]) == gen, bar);
      __builtin_amdgcn_fence(__ATOMIC_ACQUIRE, "agent");
      asm volatile("s_waitcnt vmcnt(0)" ::: "memory");
    }
  }
  __syncthreads();
}

#define PHASE_END() do { if (++ph >= p.nph) return; xcd_barrier(bar, xst); } while (0)

__global__ void __launch_bounds__(512) fwd_megakernel(const Params p) {
  cg::grid_group grid = cg::this_grid();
  __shared__ __attribute__((aligned(16))) char smem[SMEM_BYTES];
  __shared__ uint4 xb_words;
  unsigned* bar = (unsigned*)(p.ws + OFF_BAR);
  volatile LAS unsigned* xst = (volatile LAS unsigned*)&xb_words;
  if (threadIdx.x == 0) { xb_words = make_uint4(0u, 0u, 0u, 0u); (void)xb_add(&bar[XB_XCNT(xb_xcc_id())], 1u); }
  __syncthreads();
  int ph = 0;

  prep_phase(p, smem);
  if (++ph >= p.nph) return;
  grid.sync();


#pragma unroll 1
  for (int layer = 0; layer < 4; ++layer) {
    const int kind = layer % 3, j = layer / 3;
#define wsl (opqp(p.ws))
#define scr (opqp(p.ws) + OFF_SCR)
#define wt ((bf16_t*)(opqp(p.ws) + OFF_WT))
#define h ((bf16_t*)(opqp(p.ws) + OFF_H))
#define mod ((const float*)(opqp(p.ws) + OFF_MOD))
#define x (opqp(p.out))
    if (layer == 0) { norm_phase(p, 0, 0); PHASE_END(); }
    EpiArgs ea;
#define EA_FUSE(which) do { const int ridx_ = layer * 2 + (which); ea.f1 = (float*)(wsl + OFF_RSS) + (size_t)ridx_ * T_TOK; \
      ea.u0 = (unsigned*)(wsl + OFF_BAR) + CNT_WORD0 + ridx_ * 64; ea.b5 = h; \
      if ((which) == 0) { ea.c1 = p.in[opqs(10)] + layer * 1024; ea.c2 = mod + (size_t)layer * 5 * 6144 + 3 * 1024; ea.i0 = 0; } \
      else if (layer < 3) { ea.c1 = p.in[opqs(9)] + (layer + 1) * 1024; ea.c2 = mod + (size_t)(layer + 1) * 5 * 6144; ea.i0 = 0; } \
      else { ea.c1 = p.in[opqs(26)]; ea.c2 = mod; ea.i0 = 1; } } while (0)
    if (kind == 0) {
      const bf16_t* w_a = wt + (size_t)j * 786432;
      const bf16_t* w_qb = wt + 1572864 + (size_t)j * 589824;
      const bf16_t* w_kvb = wt + 2752512 + (size_t)j * 524288;
      const bf16_t* w_o = wt + 3801088 + (size_t)j * 1048576;
      ea = EpiArgs{}; ea.f0 = (float*)(scr + S_A);
      gemm_phase<EPI_F32>(h, 1024, w_a, 1024, T_TOK, 768, ea, smem);
      PHASE_END();
      mla_post_phase(p, j);
      PHASE_END();
      ea = EpiArgs{}; ea.b0 = (bf16_t*)(scr + S_Q); ea.c0 = (const float*)(wsl + OFF_CS);
      gemm_phase<EPI_Q>((const bf16_t*)(scr + S_QAN), 384, w_qb, 384, T_TOK, 1536, ea, smem);
      ea = EpiArgs{}; ea.b0 = (bf16_t*)(scr + S_KNOPE); ea.b1 = (bf16_t*)(scr + S_VT);
      gemm_phase<EPI_KV>((const bf16_t*)(scr + S_CKVN), 256, w_kvb, 256, KVROWS, 2048, ea, smem);
      PHASE_END();
      attn_phase(p, smem);
      PHASE_END();
      ea = EpiArgs{}; ea.f0 = x; ea.c0 = mod + (size_t)layer * 5 * 6144 + 2 * 1024; EA_FUSE(0);
      gemm_phase<EPI_RESIDN>((const bf16_t*)(scr + S_A), 1024, w_o, 1024, T_TOK, 1024, ea, smem);
      PHASE_END();
    } else if (kind == 1) {
      const bf16_t* w_in = wt + 5898240;
      const bf16_t* w_out = wt + 9043968;
      ea = EpiArgs{}; ea.b0 = (bf16_t*)(scr + S_BB); ea.b1 = (bf16_t*)(scr + S_Z);
      gemm_phase<EPI_CONV>(h, 1024, w_in, 1024, T_TOK, 3072, ea, smem);
      PHASE_END();
      conv_phase(p);
      PHASE_END();
      ea = EpiArgs{}; ea.f0 = x; ea.c0 = mod + (size_t)layer * 5 * 6144 + 2 * 1024; EA_FUSE(0);
      gemm_phase<EPI_RESIDN>((const bf16_t*)(scr + S_BZ), 1024, w_out, 1024, T_TOK, 1024, ea, smem);
      PHASE_END();
    } else {
      const bf16_t* w_in = wt + 10092544;
      const bf16_t* w_out = wt + 16384000;
#pragma unroll 1
      for (int hf = 0; hf < 2; ++hf) {
        ea = EpiArgs{}; ea.b0 = (bf16_t*)(scr + S_RQ); ea.b1 = (bf16_t*)(scr + S_RK); ea.b2 = (bf16_t*)(scr + S_RKT); ea.b3 = (bf16_t*)(scr + S_RVT);
        ea.b4 = (bf16_t*)(scr + S_SGY); ea.i0 = hf * 8192;
        gemm_phase<EPI_RET>(h + (size_t)hf * 8192 * 1024, 1024, w_in, 1024, 8192, 6144, ea, smem);
        PHASE_END();
        ret_scan_phase(p, hf, smem);
        PHASE_END();
        ret_intra_phase(p, hf, smem);
        PHASE_END();
      }
      ea = EpiArgs{}; ea.f0 = x; ea.c0 = mod + (size_t)layer * 5 * 6144 + 2 * 1024; EA_FUSE(0);
      gemm_phase<EPI_RESIDN>((const bf16_t*)(scr + S_SGY), 2048, w_out, 2048, T_TOK, 1024, ea, smem);
      PHASE_END();
    }
    ea = EpiArgs{}; ea.b0 = (bf16_t*)(scr + S_HID);
    gemm_phase<EPI_SWIGLU>(h, 1024, wt + 18481152 + (size_t)layer * 5767168, 1024, T_TOK, 5632, ea, smem);
    PHASE_END();
    ea = EpiArgs{}; ea.f0 = x; ea.c0 = mod + (size_t)layer * 5 * 6144 + 5 * 1024; EA_FUSE(1);
    gemm_phase<EPI_RESIDN>((const bf16_t*)(scr + S_HID), 2816, wt + 41549824 + (size_t)layer * 2883584, 2816, T_TOK, 1024, ea, smem);
    if (layer < 3) PHASE_END();
  }
}

#undef wsl
#undef scr
#undef wt
#undef h
#undef mod
#undef x
extern "C" void kernel_launch(void* const* d_in, const int* in_sizes, int n_in, void* d_out, int out_size, void* d_ws, size_t ws_size, hipStream_t stream) {
  static int grid_blocks = 0;
  if (!grid_blocks) {
    int dev = 0, cus = 0, per_cu = 0;
    (void)hipGetDevice(&dev);
    (void)hipDeviceGetAttribute(&cus, hipDeviceAttributeMultiprocessorCount, dev);
    (void)hipOccupancyMaxActiveBlocksPerMultiprocessor(&per_cu, fwd_megakernel, 512, 0);
    if (per_cu > 1) per_cu = 1;
    grid_blocks = cus * per_cu;
  }
  if (ws_size < WS_NEED) { fprintf(stderr, "workspace too small: %zu < %zu\n", ws_size, (size_t)WS_NEED); return; }
  Params p;
  memset(&p, 0, sizeof(p));
  for (int i = 0; i < 27; ++i) p.in[i] = (const float*)d_in[i];
  p.out = (float*)d_out;
  p.ws = (char*)d_ws;
  bf16_t* wt = (bf16_t*)((char*)d_ws + OFF_WT);
  int nd = 0, tiles = 0;
  auto add = [&](const float* src, size_t dst_off, int K, int N, int Npad, int mode) {
    ConvDesc& d = p.cd[nd++];
    d.src = src; d.dst = wt + dst_off; d.K = K; d.N = N; d.Npad = Npad; d.mode = mode; d.tile0 = tiles; d.pad = 0;
    tiles += (Npad / 64) * (K / 64);
  };
  const float* const* in = (const float* const*)d_in;
  const size_t O_WA = 0, O_WQB = 1572864, O_WKVB = 2752512, O_WO = 3801088, O_CIN = 5898240, O_COUT = 9043968, O_RIN = 10092544, O_ROUT = 16384000,
               O_F1 = 18481152, O_F2 = 41549824;
  auto add_mla = [&](int j) {
    add(in[11] + (size_t)j * 1024 * 704, O_WA + (size_t)j * 786432, 1024, 704, 768, 0);
    add(in[14] + (size_t)j * 384 * 1536, O_WQB + (size_t)j * 589824, 384, 1536, 1536, 0);
    add(in[15] + (size_t)j * 256 * 2048, O_WKVB + (size_t)j * 524288, 256, 2048, 2048, 0);
    add(in[16] + (size_t)j * 1024 * 1024, O_WO + (size_t)j * 1048576, 1024, 1024, 1024, 0);
  };
  auto add_ffn = [&](int i) {
    add(in[24] + (size_t)i * 1024 * 5632, O_F1 + (size_t)i * 5767168, 1024, 5632, 5632, 2);
    add(in[25] + (size_t)i * 2816 * 1024, O_F2 + (size_t)i * 2883584, 2816, 1024, 1024, 0);
  };
  add_mla(0);
  add(in[17], O_CIN, 1024, 3072, 3072, 1);
  add(in[19], O_COUT, 1024, 1024, 1024, 0);
  add(in[20], O_RIN, 1024, 6144, 6144, 0);
  add(in[23], O_ROUT, 2048, 1024, 1024, 0);
  add_ffn(0); add_ffn(1);
  p.conv_tiles_early = tiles;
  add_ffn(2); add_ffn(3);
  add_mla(1);
  p.conv_tiles = tiles;
  if (grid_blocks * 2 < 512) p.conv_tiles_early = tiles;
  p.nph = 1000;
  p.dup = 0;
  (void)hipMemsetAsync((char*)d_ws + OFF_BAR, 0, 16384, stream);
  void* args[] = {&p};
  hipError_t e = hipLaunchCooperativeKernel((void*)fwd_megakernel, dim3(grid_blocks), dim3(512), args, 0, stream);
  if (e != hipSuccess) fprintf(stderr, "cooperative launch failed: %s (grid %d)\n", hipGetErrorString(e), grid_blocks);
}
```

```cpp
#include <hip/hip_runtime.h>
#include <hip/hip_cooperative_groups.h>
#include <cstdio>
#include <cstring>
namespace cg = cooperative_groups;

typedef unsigned short bf16_t;
typedef short bf16x8 __attribute__((ext_vector_type(8)));
typedef float f32x16 __attribute__((ext_vector_type(16)));
typedef __bf16 bf2_t __attribute__((ext_vector_type(2)));
typedef float f2_t __attribute__((ext_vector_type(2)));
typedef unsigned u32x4 __attribute__((ext_vector_type(4)));
typedef unsigned u32x2 __attribute__((ext_vector_type(2)));
typedef float f32x4 __attribute__((ext_vector_type(4)));
typedef float f32x2 __attribute__((ext_vector_type(2)));

#define DI __device__ __forceinline__
#define MK4(a, b, c, d) ((u32x4){(a), (b), (c), (d)})
#define MK2(a, b) ((u32x2){(a), (b)})
#define MKF4(a, b, c, d) ((f32x4){(a), (b), (c), (d)})
#define MKF2(a, b) ((f32x2){(a), (b)})
#define MFMA(a, b, c) __builtin_amdgcn_mfma_f32_32x32x16_bf16((a), (b), (c), 0, 0, 0)

static constexpr int T_TOK = 16384;
static constexpr int TCTX = 8192;
static constexpr int KVROWS = 18432;
static constexpr float LOG2E = 1.4426950408889634f;

DI unsigned pk(float a, float b) { f2_t v = {a, b}; bf2_t r = __builtin_convertvector(v, bf2_t); return __builtin_bit_cast(unsigned, r); }
DI bf16_t bf1(float a) { return (bf16_t)(pk(a, 0.f) & 0xffffu); }
DI u32x2 pack4(float a, float b, float c, float d) { return MK2(pk(a, b), pk(c, d)); }
DI float bflo(unsigned u) { return __uint_as_float(u << 16); }
DI float bfhi(unsigned u) { return __uint_as_float(u & 0xffff0000u); }
DI int crow(int reg, int h) { return (reg & 3) + 8 * (reg >> 2) + 4 * h; }
DI float silu_f(float x) { return x * __builtin_amdgcn_rcpf(1.f + __builtin_amdgcn_exp2f(-1.4426950408889634f * x)); }
DI float ex2(float x) { return __builtin_amdgcn_exp2f(x); }
DI bf16x8 mk8(u32x2 lo, u32x2 hi) { u32x4 v = {lo.x, lo.y, hi.x, hi.y}; return __builtin_bit_cast(bf16x8, v); }
DI bf16x8 mk8(u32x4 q) { return __builtin_bit_cast(bf16x8, q); }
#define PACK8(X, S) mk8(MK4(pk((X)[8 * (S)], (X)[8 * (S) + 1]), pk((X)[8 * (S) + 2], (X)[8 * (S) + 3]), pk((X)[8 * (S) + 4], (X)[8 * (S) + 5]), pk((X)[8 * (S) + 6], (X)[8 * (S) + 7])))
DI int opaque(int v) { asm volatile("" : "+v"(v)); return v; }
DI float opaquef(float v) { asm volatile("" : "+v"(v)); return v; }
DI float shx(float v, int mask, int lane) { return __int_as_float(__builtin_amdgcn_ds_bpermute((lane ^ mask) << 2, __float_as_int(v))); }
DI int opqs(int v) { asm volatile("" : "+s"(v)); return v; }
DI int opq0() { int z = 0; asm volatile("" : "+s"(z)); return z; }
template <typename T> DI T* opqp(T* p) {
  unsigned long long v = (unsigned long long)p;
  unsigned lo = (unsigned)v, hi = (unsigned)(v >> 32);
  asm volatile("" : "+v"(lo), "+v"(hi));
  lo = __builtin_amdgcn_readfirstlane(lo); hi = __builtin_amdgcn_readfirstlane(hi);
  v = ((unsigned long long)hi << 32) | lo;
  return (T*)(__attribute__((address_space(1))) T*)v;
}
DI int cond_row(int t) { return t < TCTX ? 4 : ((t - TCTX) >> 11); }

__constant__ double c_invf[16] = {1.0, 0.5623413251903491, 0.31622776601683794, 0.1778279410038923, 0.1, 0.05623413251903491, 0.03162277660168379,
                                 0.01778279410038923, 0.01, 0.005623413251903491, 0.0031622776601683794, 0.0017782794100389228, 0.001,
                                 0.0005623413251903491, 0.00031622776601683794, 0.00017782794100389227};
struct ConvDesc { const float* src; bf16_t* dst; int K, N, Npad, mode, tile0, pad; };
static constexpr int NDESC = 20;

struct Params {
  const float* in[27];
  float* out;
  char* ws;
  ConvDesc cd[NDESC];
  int conv_tiles;
  int conv_tiles_early;
  int nph;
  int dup;
  int pad2;
};

static constexpr size_t OFF_MOD = 0;
static constexpr size_t OFF_CS = 524288;
static constexpr size_t OFF_WT = 1048576;
static constexpr size_t OFF_H = OFF_WT + 53084160ull * 2;
static constexpr size_t OFF_SCR = OFF_H + 33554432ull;
static constexpr size_t S_A = 0;
static constexpr size_t S_QAN = 50331648;
static constexpr size_t S_CKVN = 62914560;
static constexpr size_t S_KPEB = 72351744;
static constexpr size_t S_Q = 74711040;
static constexpr size_t S_KNOPE = 125042688;
static constexpr size_t S_VT = 162791424;
static constexpr size_t S_BB = 0, S_Z = 33554432, S_BZ = 67108864;
static constexpr size_t S_SGY = 0;
static constexpr size_t S_RQ = 67108864;
static constexpr size_t S_RK = 83886080;
static constexpr size_t S_RKT = 100663296;
static constexpr size_t S_RVT = 117440512;
static constexpr size_t S_CRF = 150994944;
static constexpr size_t S_CRB = 184549376;
static constexpr size_t SCR_BYTES = 218103808;
static constexpr size_t S_HID = 0;
static constexpr size_t OFF_BAR = OFF_SCR + SCR_BYTES;
static constexpr size_t OFF_RSS = OFF_BAR + 16384;
static constexpr size_t WS_NEED = OFF_RSS + 8 * 65536;
static constexpr int CNT_WORD0 = 3520;

static constexpr size_t OUT_CKV = 16777216, OUT_KPE = 20971520, OUT_STATE = 22020096;

static constexpr int SMEM_BYTES = 147456;
static constexpr int HALF_LDS = 73728;

DI void convert_tile(const Params& p, char* smem, int item, int tid) {
  int di = 0;
#pragma unroll 1
  for (int i = 1; i < NDESC; ++i) if (item >= p.cd[i].tile0) di = i;
  const ConvDesc d = p.cd[di];
  const int lt = item - d.tile0, ktiles = d.K >> 6;
  const int nt = lt / ktiles, kt = lt - nt * ktiles;
  const int n0 = nt * 64, k0 = kt * 64;
  float* tile = (float*)smem;
  {
    const int tx = tid & 63, ty = tid >> 6;
    const int np = n0 + tx;
    int sc = np;
    if (d.mode == 1) { if (np >= 1024) { int q = np - 1024, grp = q >> 5, ww = q & 31; sc = 1024 + (ww >> 4) * 1024 + grp * 16 + (ww & 15); } }
    else if (d.mode == 2) { int grp = np >> 5, ww = np & 31; sc = (ww >> 4) * 2816 + grp * 16 + (ww & 15); }
    const bool valid = np < d.N;
#pragma unroll
    for (int rr = 0; rr < 8; ++rr) {
      const int k = ty * 8 + rr;
      tile[k * 65 + tx] = valid ? d.src[(size_t)(k0 + k) * d.N + sc] : 0.f;
    }
  }
  __syncthreads();
  {
    const int nl = tid >> 3, ks = (tid & 7) * 8;
    unsigned u[4];
#pragma unroll
    for (int i = 0; i < 4; ++i) u[i] = pk(tile[(ks + 2 * i) * 65 + nl], tile[(ks + 2 * i + 1) * 65 + nl]);
    *(u32x4*)(d.dst + (size_t)(n0 + nl) * d.K + k0 + ks) = MK4(u[0], u[1], u[2], u[3]);
  }
  __syncthreads();
}

DI void prep_phase(const Params& p, char* smem) {
  char* ws_ = opqp(p.ws); float* out_ = opqp(p.out);
  { float* rss = (float*)(ws_ + OFF_RSS); for (int i = blockIdx.x * 512 + (int)threadIdx.x; i < 8 * T_TOK; i += gridDim.x * 512) rss[i] = 0.f; }
  const int tid = opaque((int)threadIdx.x), lane = tid & 63, w = tid >> 6;
  const int n_conv = p.conv_tiles_early, n_ada = 192, n_cs = 128;
  const int total = n_conv + n_ada + n_cs;
  for (int item = blockIdx.x; item < total; item += gridDim.x) {
    if (item < n_conv) {
      convert_tile(p, smem, item, tid);
    } else if (item < n_conv + n_ada) {
      const int it = item - n_conv, layer = it / 48, cb = it % 48;
      float* ssil = (float*)smem;
      float* red = ssil + 5 * 1024;
      for (int i = tid; i < 5 * 1024; i += 512) {
        const int rr = i >> 10, k = i & 1023;
        const float v = rr < 4 ? p.in[opqs(2)][rr * 1024 + k] : p.in[opqs(3)][k];
        ssil[i] = silu_f(v);
      }
      __syncthreads();
      const float* W = p.in[opqs(7)] + (size_t)layer * 1024 * 6144 + cb * 128 + lane * 2;
      float acc[5][2];
#pragma unroll
      for (int rr = 0; rr < 5; ++rr) { acc[rr][0] = 0.f; acc[rr][1] = 0.f; }
#pragma unroll 4
      for (int kk = 0; kk < 128; ++kk) {
        const int k = w * 128 + kk;
        const f32x2 wv = *(const f32x2*)(W + (size_t)k * 6144);
#pragma unroll
        for (int rr = 0; rr < 5; ++rr) { const float s = ssil[rr * 1024 + k]; acc[rr][0] += s * wv.x; acc[rr][1] += s * wv.y; }
      }
#pragma unroll
      for (int rr = 0; rr < 5; ++rr) { red[(w * 5 + rr) * 128 + lane * 2] = acc[rr][0]; red[(w * 5 + rr) * 128 + lane * 2 + 1] = acc[rr][1]; }
      __syncthreads();
      float* mod = (float*)(ws_ + OFF_MOD);
      for (int i = tid; i < 640; i += 512) {
        const int rr = i >> 7, cn = i & 127;
        float s = p.in[opqs(8)][layer * 6144 + cb * 128 + cn];
#pragma unroll
        for (int ww = 0; ww < 8; ++ww) s += red[(ww * 5 + rr) * 128 + cn];
        mod[(size_t)(layer * 5 + rr) * 6144 + cb * 128 + cn] = s;
      }
      __syncthreads();
    } else {
      const int idx = (item - n_conv - n_ada) * 512 + tid;
      const int pos = idx >> 5, e = idx & 31, axis = e >> 4, f = e & 15;
      const double iv = c_invf[f];
      const float pf = (float)(axis == 0 ? (pos >> 6) : (pos & 63));
      const float angf = pf * (float)iv;
      const double ang = (double)angf;
      const double kq = rint(ang * 0.6366197723675814);
      const double rr = ang - kq * 1.5707963267948966;
      const double r2 = rr * rr;
      const double sn = rr * (1.0 + r2 * (-1.0 / 6 + r2 * (1.0 / 120 + r2 * (-1.0 / 5040 + r2 * (1.0 / 362880 + r2 * (-1.0 / 39916800 + r2 * (1.0 / 6227020800.0)))))));
      const double cn = 1.0 + r2 * (-0.5 + r2 * (1.0 / 24 + r2 * (-1.0 / 720 + r2 * (1.0 / 40320 + r2 * (-1.0 / 3628800 + r2 * (1.0 / 479001600.0))))));
      const int qd = ((int)kq) & 3;
      double c, s;
      if (qd == 0) { c = cn; s = sn; } else if (qd == 1) { c = -sn; s = cn; } else if (qd == 2) { c = -cn; s = -sn; } else { c = sn; s = -cn; }
      f32x2* cs = (f32x2*)(ws_ + OFF_CS);
      cs[idx] = MKF2((float)c, (float)s);
    }
  }
}

DI void norm_phase(const Params& p, int layer, int which  ) {
  char* ws_ = opqp(p.ws); float* out_ = opqp(p.out);
  const int tid = opaque((int)threadIdx.x), lane = tid & 63, w = tid >> 6;
  float* x = out_;
  bf16_t* h = (bf16_t*)(ws_ + OFF_H);
  const float* mod = (const float*)(ws_ + OFF_MOD);
  const bool first = (layer == 0 && which == 0);
  const float* g = which == 2 ? p.in[opqs(26)] : (which == 0 ? p.in[opqs(9)] + layer * 1024 : p.in[opqs(10)] + layer * 1024);
  for (int t = blockIdx.x * 8 + w; t < T_TOK; t += gridDim.x * 8) {
    const float* src = first ? (t < TCTX ? p.in[opqs(0)] + (size_t)t * 1024 : p.in[opqs(1)] + (size_t)(t - TCTX) * 1024) : x + (size_t)t * 1024;
    f32x4 v[4];
    float ss = 0.f;
#pragma unroll
    for (int q = 0; q < 4; ++q) { v[q] = *(const f32x4*)(src + q * 256 + lane * 4); ss += v[q].x * v[q].x + v[q].y * v[q].y + v[q].z * v[q].z + v[q].w * v[q].w; }
#pragma unroll
    for (int o = 32; o >= 1; o >>= 1) ss += shx(ss, o, lane);
    const float rstd = rsqrtf(ss * (1.f / 1024.f) + 1e-6f);
    if (which == 2) {
#pragma unroll
      for (int q = 0; q < 4; ++q) {
        const int col = q * 256 + lane * 4;
        const f32x4 gg = *(const f32x4*)(g + col);
        f32x4 y; y.x = v[q].x * rstd * gg.x; y.y = v[q].y * rstd * gg.y; y.z = v[q].z * rstd * gg.z; y.w = v[q].w * rstd * gg.w;
        *(f32x4*)(x + (size_t)t * 1024 + col) = y;
      }
    } else {
      const int cr = cond_row(t);
      const float* sh = mod + (size_t)(layer * 5 + cr) * 6144 + (which == 0 ? 0 : 3) * 1024;
      const float* sc = sh + 1024;
#pragma unroll
      for (int q = 0; q < 4; ++q) {
        const int col = q * 256 + lane * 4;
        const f32x4 gg = *(const f32x4*)(g + col), s4 = *(const f32x4*)(sc + col), h4 = *(const f32x4*)(sh + col);
        const float y0 = v[q].x * rstd * gg.x * (1.f + s4.x) + h4.x, y1 = v[q].y * rstd * gg.y * (1.f + s4.y) + h4.y;
        const float y2 = v[q].z * rstd * gg.z * (1.f + s4.z) + h4.z, y3 = v[q].w * rstd * gg.w * (1.f + s4.w) + h4.w;
        *(u32x2*)(h + (size_t)t * 1024 + col) = pack4(y0, y1, y2, y3);
        if (first) *(f32x4*)(x + (size_t)t * 1024 + col) = v[q];
      }
    }
  }
}

enum { EPI_F32 = 0, EPI_Q, EPI_KV, EPI_RESID, EPI_SWIGLU, EPI_CONV, EPI_RET, EPI_RESIDN };
struct EpiArgs { float* f0; bf16_t* b0; bf16_t* b1; bf16_t* b2; bf16_t* b3; bf16_t* b4; const float* c0; int i0;
                 const float* c1; const float* c2; float* f1; bf16_t* b5; unsigned* u0; };

template <int EPI>
DI void epilogue(const EpiArgs& ea, int m, int nb, int h5, f32x16& acc) {
  if (EPI == EPI_F32) {
#pragma unroll
    for (int g = 0; g < 4; ++g) *(f32x4*)(ea.f0 + (size_t)m * 768 + nb + 8 * g + 4 * h5) = MKF4(acc[4 * g], acc[4 * g + 1], acc[4 * g + 2], acc[4 * g + 3]);
  } else if (EPI == EPI_Q) {
    const int dd = nb % 192;
    if (dd >= 128 && m >= TCTX) {
      const int pos = (m - TCTX) & 2047, axis = (dd - 128) >> 5;
      const f32x2* cs = (const f32x2*)ea.c0 + pos * 32 + axis * 16;
#pragma unroll
      for (int i = 0; i < 8; ++i) {
        const int f = 8 * (i >> 2) + 4 * h5 + (i & 3);
        const f32x2 c = cs[f];
        const float x1 = acc[i], x2 = acc[i + 8];
        acc[i] = x1 * c.x - x2 * c.y;
        acc[i + 8] = x2 * c.x + x1 * c.y;
      }
    }
#pragma unroll
    for (int g = 0; g < 4; ++g) *(u32x2*)(ea.b0 + (size_t)m * 1536 + nb + 8 * g + 4 * h5) = pack4(acc[4 * g], acc[4 * g + 1], acc[4 * g + 2], acc[4 * g + 3]);
  } else if (EPI == EPI_KV) {
    const int hd = nb >> 8, dd = nb & 255;
    if (dd < 128) {
#pragma unroll
      for (int g = 0; g < 4; ++g) *(u32x2*)(ea.b0 + (size_t)m * 1024 + hd * 128 + dd + 8 * g + 4 * h5) = pack4(acc[4 * g], acc[4 * g + 1], acc[4 * g + 2], acc[4 * g + 3]);
    } else {
#pragma unroll
      for (int i = 0; i < 16; ++i) ea.b1[(size_t)(hd * 128 + dd - 128 + crow(i, h5)) * KVROWS + m] = bf1(acc[i]);
    }
  } else if (EPI == EPI_RESID) {
    const int cr = cond_row(m);
#pragma unroll
    for (int g = 0; g < 4; ++g) {
      const int n = nb + 8 * g + 4 * h5;
      f32x4 xv = *(f32x4*)(ea.f0 + (size_t)m * 1024 + n);
      const f32x4 gv = *(const f32x4*)(ea.c0 + (size_t)cr * 6144 + n);
      xv.x += gv.x * acc[4 * g]; xv.y += gv.y * acc[4 * g + 1]; xv.z += gv.z * acc[4 * g + 2]; xv.w += gv.w * acc[4 * g + 3];
      *(f32x4*)(ea.f0 + (size_t)m * 1024 + n) = xv;
    }
  } else if (EPI == EPI_SWIGLU) {
    const int chb = (nb >> 5) * 16;
#pragma unroll
    for (int g = 0; g < 2; ++g)
      *(u32x2*)(ea.b0 + (size_t)m * 2816 + chb + 8 * g + 4 * h5) =
          pack4(silu_f(acc[4 * g]) * acc[4 * g + 8], silu_f(acc[4 * g + 1]) * acc[4 * g + 9], silu_f(acc[4 * g + 2]) * acc[4 * g + 10], silu_f(acc[4 * g + 3]) * acc[4 * g + 11]);
  } else if (EPI == EPI_CONV) {
    if (nb < 1024) {
#pragma unroll
      for (int g = 0; g < 4; ++g) *(u32x2*)(ea.b0 + (size_t)m * 1024 + nb + 8 * g + 4 * h5) = pack4(acc[4 * g], acc[4 * g + 1], acc[4 * g + 2], acc[4 * g + 3]);
    } else {
      const int chb = ((nb - 1024) >> 5) * 16;
#pragma unroll
      for (int g = 0; g < 2; ++g)
        *(u32x2*)(ea.b1 + (size_t)m * 1024 + chb + 8 * g + 4 * h5) =
            pack4(acc[4 * g] * acc[4 * g + 8], acc[4 * g + 1] * acc[4 * g + 9], acc[4 * g + 2] * acc[4 * g + 10], acc[4 * g + 3] * acc[4 * g + 11]);
    }
  } else if (EPI == EPI_RET) {
    if (nb < 1024) {
#pragma unroll
      for (int g = 0; g < 4; ++g) *(u32x2*)(ea.b0 + (size_t)m * 1024 + nb + 8 * g + 4 * h5) = pack4(acc[4 * g], acc[4 * g + 1], acc[4 * g + 2], acc[4 * g + 3]);
    } else if (nb < 2048) {
      const int c0 = nb - 1024;
#pragma unroll
      for (int i = 0; i < 16; ++i) acc[i] *= 0.0625f;
#pragma unroll
      for (int g = 0; g < 4; ++g) *(u32x2*)(ea.b1 + (size_t)m * 1024 + c0 + 8 * g + 4 * h5) = pack4(acc[4 * g], acc[4 * g + 1], acc[4 * g + 2], acc[4 * g + 3]);
#pragma unroll
      for (int i = 0; i < 16; ++i) ea.b2[(size_t)(c0 + crow(i, h5)) * 8192 + m] = bf1(acc[i]);
    } else if (nb < 4096) {
      const int c0 = nb - 2048;
#pragma unroll
      for (int i = 0; i < 16; ++i) ea.b3[(size_t)(c0 + crow(i, h5)) * 8192 + m] = bf1(acc[i]);
    } else {
      const int c0 = nb - 4096;
#pragma unroll
      for (int g = 0; g < 4; ++g)
        *(u32x2*)(ea.b4 + (size_t)(m + ea.i0) * 2048 + c0 + 8 * g + 4 * h5) = pack4(silu_f(acc[4 * g]), silu_f(acc[4 * g + 1]), silu_f(acc[4 * g + 2]), silu_f(acc[4 * g + 3]));
    }
  }
}

template <int EPI>
DI void gemm_phase(const bf16_t* A, int lda, const bf16_t* Bt, int K, int M, int N, const EpiArgs ea_in, char* smem) {
  const int tid = opaque((int)threadIdx.x), lane = tid & 63, w = tid >> 6, wm = w >> 2, wn = w & 3, r = lane & 31, h5 = lane >> 5;
  constexpr int BUF = 73728, AOFF = 0, BOFF = 36864;
  A = opqp(A); Bt = opqp(Bt);
  EpiArgs ea = ea_in;
  ea.f0 = opqp(ea.f0); ea.b0 = opqp(ea.b0); ea.b1 = opqp(ea.b1); ea.b2 = opqp(ea.b2); ea.b3 = opqp(ea.b3); ea.b4 = opqp(ea.b4); ea.c0 = opqp(ea.c0);
  if (EPI == EPI_RESIDN) { ea.c1 = opqp(ea.c1); ea.c2 = opqp(ea.c2); ea.f1 = opqp(ea.f1); ea.b5 = opqp(ea.b5); ea.u0 = opqp(ea.u0); }
  const int MT = M >> 8, NT = N >> 8, ntiles = MT * NT, KT = K >> 6;
  const int gfull = 32 * NT;
  const int lrow = tid >> 3, lkc = tid & 7;
  for (int id = blockIdx.x; id < ntiles; id += gridDim.x) {
    const int g = id / gfull, within = id - g * gfull;
    const int mrem = MT - g * 32, gm = mrem < 32 ? mrem : 32;
    const int mt = g * 32 + within % gm, nt = within / gm;
    const int m0 = mt << 8, n0 = nt << 8;
    f32x16 acc[4][2];
#pragma unroll
    for (int a = 0; a < 4; ++a)
#pragma unroll
      for (int b = 0; b < 2; ++b)
#pragma unroll
        for (int i = 0; i < 16; ++i) acc[a][b][i] = 0.f;
    u32x4 ra[4], rb[4];
    const char* Ab = (const char*)(A + (size_t)m0 * lda);
    const char* Bb = (const char*)(Bt + (size_t)n0 * K);
    const unsigned voa = (unsigned)(lrow * lda + lkc * 8) * 2u, vob = (unsigned)(lrow * K + lkc * 8) * 2u;
#define G_LOADP(s, k0) do { const char* as_ = Ab + ((size_t)(64 * (s)) * lda + (k0)) * 2; const char* bs_ = Bb + ((size_t)(64 * (s)) * K + (k0)) * 2; \
      ra[s] = *(const u32x4*)(as_ + voa); rb[s] = *(const u32x4*)(bs_ + vob); } while (0)
#define G_STOREP(s, buf) do { char* sb_ = smem + (buf) * BUF + lrow * 144 + lkc * 16 + (s) * 64 * 144; \
      *(u32x4*)(sb_ + AOFF) = ra[s]; *(u32x4*)(sb_ + BOFF) = rb[s]; } while (0)
#define G_ITER(buf, kt_) do { \
      const char* sa = smem + (buf) * BUF + AOFF + (128 * wm + r) * 144 + h5 * 16; \
      const char* sb = smem + (buf) * BUF + BOFF + (64 * wn + r) * 144 + h5 * 16; \
      _Pragma("unroll") for (int s = 0; s < 4; ++s) { \
        bf16x8 af[4], bfr[2]; \
        _Pragma("unroll") for (int a = 0; a < 4; ++a) af[a] = *(const bf16x8*)(sa + a * 32 * 144 + s * 32); \
        _Pragma("unroll") for (int b = 0; b < 2; ++b) bfr[b] = *(const bf16x8*)(sb + b * 32 * 144 + s * 32); \
        if ((kt_) + 1 < KT) G_STOREP(s, (buf) ^ 1); \
        if ((kt_) + 2 < KT) G_LOADP(s, ((kt_) + 2) << 6); \
        __builtin_amdgcn_sched_barrier(0); \
        _Pragma("unroll") for (int a = 0; a < 4; ++a) \
          _Pragma("unroll") for (int b = 0; b < 2; ++b) acc[a][b] = MFMA(bfr[b], af[a], acc[a][b]); \
        __builtin_amdgcn_sched_barrier(0); \
      } } while (0)
#pragma unroll
    for (int s = 0; s < 4; ++s) G_LOADP(s, 0);
#pragma unroll
    for (int s = 0; s < 4; ++s) G_STOREP(s, 0);
#pragma unroll
    for (int s = 0; s < 4; ++s) G_LOADP(s, 64);
    __syncthreads();
    for (int kt = 0; kt < KT; kt += 2) {
      G_ITER(0, kt);
      __syncthreads();
      G_ITER(1, kt + 1);
      __syncthreads();
    }
#undef G_ITER
#undef G_LOADP
#undef G_STOREP
    if (EPI == EPI_SWIGLU) {
#pragma unroll
      for (int a = 0; a < 4; ++a)
#pragma unroll
        for (int b = 0; b < 2; ++b)
#pragma unroll
          for (int g = 0; g < 2; ++g) {
            const f32x16& c = acc[a][b];
            *(u32x2*)(smem + (128 * wm + 32 * a + r) * 272 + (32 * wn + 16 * b + 8 * g + 4 * h5) * 2) =
                pack4(silu_f(c[4 * g]) * c[4 * g + 8], silu_f(c[4 * g + 1]) * c[4 * g + 9], silu_f(c[4 * g + 2]) * c[4 * g + 10], silu_f(c[4 * g + 3]) * c[4 * g + 11]);
          }
      __syncthreads();
      {
        bf16_t* outp = ea.b0 + (size_t)m0 * 2816 + (n0 >> 1);
#pragma unroll
        for (int ps = 0; ps < 8; ++ps) {
          const int c = tid + 512 * ps, row = c >> 4, part = c & 15;
          *(u32x4*)(outp + (size_t)row * 2816 + part * 8) = *(const u32x4*)(smem + row * 272 + part * 16);
        }
      }
      __syncthreads();
    } else if (EPI == EPI_RESIDN) {
#pragma unroll
      for (int a = 0; a < 4; ++a) {
        const int m = m0 + 128 * wm + 32 * a + r;
        const int cr = cond_row(m);
        float ss = 0.f;
#pragma unroll
        for (int b = 0; b < 2; ++b) {
          f32x4 xin[4], gin[4];
#pragma unroll
          for (int g = 0; g < 4; ++g) {
            const int n = n0 + 64 * wn + 32 * b + 8 * g + 4 * h5;
            xin[g] = *(const f32x4*)(ea.f0 + (size_t)m * 1024 + n);
            gin[g] = *(const f32x4*)(ea.c0 + (size_t)cr * 6144 + n);
          }
#pragma unroll
          for (int g = 0; g < 4; ++g) {
            const int n = n0 + 64 * wn + 32 * b + 8 * g + 4 * h5;
            f32x4 xv = xin[g];
            const f32x4 gv = gin[g];
            xv.x += gv.x * acc[a][b][4 * g]; xv.y += gv.y * acc[a][b][4 * g + 1]; xv.z += gv.z * acc[a][b][4 * g + 2]; xv.w += gv.w * acc[a][b][4 * g + 3];
            if (ea.i0 == 0) *(f32x4*)(ea.f0 + (size_t)m * 1024 + n) = xv;
            acc[a][b][4 * g] = xv.x; acc[a][b][4 * g + 1] = xv.y; acc[a][b][4 * g + 2] = xv.z; acc[a][b][4 * g + 3] = xv.w;
            ss += xv.x * xv.x + xv.y * xv.y + xv.z * xv.z + xv.w * xv.w;
          }
        }
        ss += shx(ss, 32, lane);
        if (h5 == 0) { const float prev = atomicAdd(ea.f1 + m, ss); asm volatile("" :: "v"(prev)); }
        __builtin_amdgcn_sched_barrier(0);
      }
      asm volatile("s_waitcnt vmcnt(0)" ::: "memory");
      __syncthreads();
      if (tid == 0) {
        unsigned* c = ea.u0 + mt;
        __hip_atomic_fetch_add(c, 1u, __ATOMIC_RELAXED, __HIP_MEMORY_SCOPE_AGENT);
        unsigned spins = 0;
        while (__hip_atomic_load(c, __ATOMIC_RELAXED, __HIP_MEMORY_SCOPE_AGENT) < (unsigned)NT) { __builtin_amdgcn_s_sleep(1); if (++spins > (1u << 22)) break; }
      }
      asm volatile("" ::: "memory");
      __syncthreads();
#pragma unroll
      for (int a = 0; a < 4; ++a) {
        const int m = m0 + 128 * wm + 32 * a + r;
        const int cr = cond_row(m);
        const float rstd = rsqrtf(__hip_atomic_load(ea.f1 + m, __ATOMIC_RELAXED, __HIP_MEMORY_SCOPE_AGENT) * (1.f / 1024.f) + 1e-6f);
#pragma unroll
        for (int b = 0; b < 2; ++b)
#pragma unroll
          for (int g = 0; g < 4; ++g) {
            const int n = n0 + 64 * wn + 32 * b + 8 * g + 4 * h5;
            const f32x4 gn = *(const f32x4*)(ea.c1 + n);
            const float y0 = acc[a][b][4 * g] * rstd * gn.x, y1 = acc[a][b][4 * g + 1] * rstd * gn.y, y2 = acc[a][b][4 * g + 2] * rstd * gn.z, y3 = acc[a][b][4 * g + 3] * rstd * gn.w;
            if (ea.i0 == 0) {
              const f32x4 sh = *(const f32x4*)(ea.c2 + (size_t)cr * 6144 + n), sc = *(const f32x4*)(ea.c2 + 1024 + (size_t)cr * 6144 + n);
              *(u32x2*)(ea.b5 + (size_t)m * 1024 + n) = pack4(y0 * (1.f + sc.x) + sh.x, y1 * (1.f + sc.y) + sh.y, y2 * (1.f + sc.z) + sh.z, y3 * (1.f + sc.w) + sh.w);
            } else {
              *(f32x4*)(ea.f0 + (size_t)m * 1024 + n) = MKF4(y0, y1, y2, y3);
            }
          }
        __builtin_amdgcn_sched_barrier(0);
      }
    } else {
#pragma unroll
      for (int a = 0; a < 4; ++a)
#pragma unroll
        for (int b = 0; b < 2; ++b) { epilogue<EPI>(ea, m0 + 128 * wm + 32 * a + r, n0 + 64 * wn + 32 * b, h5, acc[a][b]); __builtin_amdgcn_sched_barrier(0); }
    }
  }
}

DI void mla_post_phase(const Params& p, int j) {
  char* ws_ = opqp(p.ws); float* out_ = opqp(p.out);
  const int tid = opaque((int)threadIdx.x), lane = tid & 63, w = tid >> 6;
  const float* a = (const float*)(ws_ + OFF_SCR + S_A);
  bf16_t* qan = (bf16_t*)(ws_ + OFF_SCR + S_QAN);
  bf16_t* ckvn = (bf16_t*)(ws_ + OFF_SCR + S_CKVN);
  bf16_t* kpeb = (bf16_t*)(ws_ + OFF_SCR + S_KPEB);
  const f32x2* cs = (const f32x2*)(ws_ + OFF_CS);
  const float* gq = p.in[opqs(12)] + j * 384;
  const float* gkv = p.in[opqs(13)] + j * 256;
  for (int rw = blockIdx.x * 8 + w; rw < KVROWS; rw += gridDim.x * 8) {
    int t = -1, pos = 0, cb = 0, cp = 0;
    if (rw < TCTX) t = rw;
    else {
      const int rr = rw - TCTX; cb = rr / 2560; const int pp = rr - cb * 2560;
      if (pp < 512) cp = pp; else { pos = pp - 512; t = TCTX + cb * 2048 + pos; }
    }
    if (t >= 0) {
      const float* ar = a + (size_t)t * 768;
      f32x2 gqv[3];
#pragma unroll
      for (int q = 0; q < 3; ++q) gqv[q] = *(const f32x2*)(gq + q * 128 + lane * 2);
      const f32x4 g4 = *(const f32x4*)(gkv + lane * 4);
      const f32x2 csv = cs[(t < TCTX ? 0 : pos) * 32 + (lane >> 5) * 16 + (lane & 15)];
      f32x2 qv[3]; float ss = 0.f;
#pragma unroll
      for (int q = 0; q < 3; ++q) { qv[q] = *(const f32x2*)(ar + q * 128 + lane * 2); ss += qv[q].x * qv[q].x + qv[q].y * qv[q].y; }
      const f32x4 cv = *(const f32x4*)(ar + 384 + lane * 4);
      float s2 = cv.x * cv.x + cv.y * cv.y + cv.z * cv.z + cv.w * cv.w;
      const float kv = ar[640 + lane];
#pragma unroll
      for (int o = 32; o >= 1; o >>= 1) { ss += shx(ss, o, lane); s2 += shx(s2, o, lane); }
      const float rq = rsqrtf(ss * (1.f / 384.f) + 1e-6f), rc = rsqrtf(s2 * (1.f / 256.f) + 1e-6f);
#pragma unroll
      for (int q = 0; q < 3; ++q) {
        const int col = q * 128 + lane * 2;
        *(unsigned*)(qan + (size_t)t * 384 + col) = pk(qv[q].x * rq * gqv[q].x, qv[q].y * rq * gqv[q].y);
      }
      const float c0 = cv.x * rc * g4.x, c1 = cv.y * rc * g4.y, c2 = cv.z * rc * g4.z, c3 = cv.w * rc * g4.w;
      *(u32x2*)(ckvn + (size_t)rw * 256 + lane * 4) = pack4(c0, c1, c2, c3);
      float ko = kv;
      if (t < TCTX) {
        const int b = t >> 8, s = t & 255;
        *(f32x4*)(out_ + OUT_CKV + ((size_t)(b * 2 + j) * 256 + s) * 256 + lane * 4) = MKF4(c0, c1, c2, c3);
        out_[OUT_KPE + ((size_t)(b * 2 + j) * 256 + s) * 64 + lane] = kv;
      } else {
        const float partner = shx(kv, 16, lane);
        const int axis = lane >> 5, half = (lane >> 4) & 1, f = lane & 15;
        const f32x2 c = csv; (void)axis; (void)f;
        ko = half ? (kv * c.x + partner * c.y) : (kv * c.x - partner * c.y);
      }
      kpeb[(size_t)rw * 64 + lane] = bf1(ko);
    } else {
      const float* cr = p.in[opqs(4)] + ((size_t)(cb * 2 + j) * 512 + cp) * 256;
      const f32x4 cv = *(const f32x4*)(cr + lane * 4);
      *(u32x2*)(ckvn + (size_t)rw * 256 + lane * 4) = pack4(cv.x, cv.y, cv.z, cv.w);
      kpeb[(size_t)rw * 64 + lane] = bf1(p.in[opqs(5)][((size_t)(cb * 2 + j) * 512 + cp) * 64 + lane]);
    }
  }
}

DI void attn_phase(const Params& p, char* smem) {
  char* ws_ = opqp(p.ws); float* out_ = opqp(p.out);
  const int tid0 = opaque((int)threadIdx.x), tid = tid0 & 255, vb = blockIdx.x * 2 + (tid0 >> 8), vg = gridDim.x * 2, lane = tid & 63, w = tid >> 6, r = lane & 31, h5 = lane >> 5;
  smem += (tid0 >> 8) * HALF_LDS;
  const bf16_t* q = (const bf16_t*)(ws_ + OFF_SCR + S_Q);
  const bf16_t* knope = (const bf16_t*)(ws_ + OFF_SCR + S_KNOPE);
  const bf16_t* kpeb = (const bf16_t*)(ws_ + OFF_SCR + S_KPEB);
  const bf16_t* vT = (const bf16_t*)(ws_ + OFF_SCR + S_VT);
  bf16_t* o = (bf16_t*)(ws_ + OFF_SCR + S_A);
  char* sK = smem;
  char* sV = smem + 25600;
  const float scl = 0.07216878364870322f * LOG2E;
  for (int item = vb; item < 1024; item += vg) {
    int hd, qtok0, krow0, nk;
    if (item < 512) { const int b = item >> 7; hd = (item >> 4) & 7; const int qb = item & 15; qtok0 = TCTX + b * 2048 + qb * 128; krow0 = TCTX + b * 2560; nk = 2560; }
    else { const int it = item - 512; const int b = it >> 4; hd = (it >> 1) & 7; const int qb = it & 1; qtok0 = b * 256 + qb * 128; krow0 = b * 256; nk = 256; }
    bf16x8 qf[12];
    {
      const bf16_t* qp = q + (size_t)(qtok0 + 32 * w + r) * 1536 + hd * 192 + 8 * h5;
#pragma unroll
      for (int s = 0; s < 12; ++s) qf[s] = *(const bf16x8*)(qp + 16 * s);
    }
    f32x16 oacc[4];
#pragma unroll
    for (int d = 0; d < 4; ++d)
#pragma unroll
      for (int i = 0; i < 16; ++i) oacc[d][i] = 0.f;
    float m_run = -1e30f, l_run = 0.f;
    const int nkt = nk >> 6;
    u32x4 pkr[6], pvr[4];
#define ATT_LOAD(kt_) do { const int kr_ = krow0 + (kt_) * 64; const int tidl = opaque((int)threadIdx.x) & 255; \
      _Pragma("unroll") for (int qq = 0; qq < 6; ++qq) { \
        const int c = tidl + 256 * qq, row = c / 24, cc = c - row * 24; \
        const bf16_t* src_ = cc < 16 ? knope + (size_t)(kr_ + row) * 1024 + hd * 128 + cc * 8 : kpeb + (size_t)(kr_ + row) * 64 + (cc - 16) * 8; \
        pkr[qq] = *(const u32x4*)src_; } \
      _Pragma("unroll") for (int qq = 0; qq < 4; ++qq) { \
        const int c = tidl + 256 * qq, row = c >> 3, cc = c & 7; \
        pvr[qq] = *(const u32x4*)(vT + (size_t)(hd * 128 + row) * KVROWS + kr_ + cc * 8); } } while (0)
    ATT_LOAD(0);
    for (int kt = 0; kt < nkt; ++kt) {
      __syncthreads();
      {
        const int tidl = opaque((int)threadIdx.x) & 255;
#pragma unroll
        for (int qq = 0; qq < 6; ++qq) {
          const int c = tidl + 256 * qq, row = c / 24, cc = c - row * 24;
          *(u32x4*)(sK + row * 400 + cc * 16) = pkr[qq];
        }
#pragma unroll
        for (int qq = 0; qq < 4; ++qq) {
          const int c = tidl + 256 * qq, row = c >> 3, cc = c & 7;
          *(u32x2*)(sV + row * 136 + cc * 16) = MK2(pvr[qq].x, pvr[qq].y);
          *(u32x2*)(sV + row * 136 + cc * 16 + 8) = MK2(pvr[qq].z, pvr[qq].w);
        }
      }
      __syncthreads();
      if (kt + 1 < nkt) ATT_LOAD(kt + 1);
      __builtin_amdgcn_sched_barrier(0);
      f32x16 st[2];
#pragma unroll
      for (int kb = 0; kb < 2; ++kb)
#pragma unroll
        for (int i = 0; i < 16; ++i) st[kb][i] = 0.f;
      {
        const char* kbase = sK + r * 400 + (8 * h5) * 2;
        bf16x8 kr[4];
#define QK_READ(i) kr[(i) & 3] = *(const bf16x8*)(kbase + (32 * ((i) / 12)) * 400 + (16 * ((i) % 12)) * 2)
        QK_READ(0); QK_READ(1); QK_READ(2);
        __builtin_amdgcn_sched_barrier(0);
#pragma unroll
        for (int i = 0; i < 24; ++i) {
          if (i + 3 < 24) QK_READ(i + 3);
          __builtin_amdgcn_sched_barrier(0);
          st[i / 12] = MFMA(kr[i & 3], qf[i % 12], st[i / 12]);
          __builtin_amdgcn_sched_barrier(0);
        }
#undef QK_READ
      }
      float mx = -1e30f;
#pragma unroll
      for (int kb = 0; kb < 2; ++kb)
#pragma unroll
        for (int i = 0; i < 16; ++i) { st[kb][i] *= scl; mx = fmaxf(mx, st[kb][i]); }
      mx = fmaxf(mx, shx(mx, 32, lane));
      const float mnew = fmaxf(m_run, mx);
      const float alpha = ex2(m_run - mnew);
      m_run = mnew;
      float psum = 0.f;
#pragma unroll
      for (int kb = 0; kb < 2; ++kb)
#pragma unroll
        for (int i = 0; i < 16; ++i) { const float pv = ex2(st[kb][i] - mnew); st[kb][i] = pv; psum += pv; }
      l_run = l_run * alpha + psum;
#pragma unroll
      for (int d = 0; d < 4; ++d)
#pragma unroll
        for (int i = 0; i < 16; ++i) oacc[d][i] *= alpha;
      {
        const char* vbase = sV + r * 136 + (4 * h5) * 2;
        u32x2 vlo[4], vhi[4];
#define PV_READ(j) do { const char* ap_ = vbase + (32 * ((j) & 3)) * 136 + (16 * ((j) >> 2)) * 2; vlo[(j) & 3] = *(const u32x2*)ap_; vhi[(j) & 3] = *(const u32x2*)(ap_ + 16); } while (0)
        PV_READ(0); PV_READ(1); PV_READ(2);
        bf16x8 bfr = PACK8(st[0], 0);
        __builtin_amdgcn_sched_barrier(0);
#pragma unroll
        for (int j = 0; j < 16; ++j) {
          if (j + 3 < 16) PV_READ(j + 3);
          if ((j & 3) == 0 && j > 0) bfr = PACK8(st[j >> 3], ((j >> 2) & 1));
          __builtin_amdgcn_sched_barrier(0);
          oacc[j & 3] = MFMA(mk8(vlo[j & 3], vhi[j & 3]), bfr, oacc[j & 3]);
          __builtin_amdgcn_sched_barrier(0);
        }
#undef PV_READ
      }
    }
    const float ltot = l_run + shx(l_run, 32, lane);
    const float inv = 1.f / ltot;
    bf16_t* op = o + (size_t)(qtok0 + 32 * w + r) * 1024 + hd * 128 + 4 * h5;
#pragma unroll
    for (int d = 0; d < 4; ++d)
#pragma unroll
      for (int g = 0; g < 4; ++g)
        *(u32x2*)(op + 32 * d + 8 * g) = pack4(oacc[d][4 * g] * inv, oacc[d][4 * g + 1] * inv, oacc[d][4 * g + 2] * inv, oacc[d][4 * g + 3] * inv);
  }
}

DI void conv_phase(const Params& p) {
  char* ws_ = opqp(p.ws); float* out_ = opqp(p.out);
  const bf16_t* bb = (const bf16_t*)(ws_ + OFF_SCR + S_BB);
  const bf16_t* z = (const bf16_t*)(ws_ + OFF_SCR + S_Z);
  bf16_t* bz = (bf16_t*)(ws_ + OFF_SCR + S_BZ);
  const float* cw = p.in[opqs(18)];
  const int tid = opaque((int)threadIdx.x);
  for (int idx = blockIdx.x * 512 + tid; idx < T_TOK * 128; idx += gridDim.x * 512) {
    const int t = idx >> 7, c8 = (idx & 127) * 8;
    const int L = t < TCTX ? 256 : 2048, pos = t & (L - 1);
    const u32x4 bv = *(const u32x4*)(bb + (size_t)t * 1024 + c8);
    const u32x4 z1 = *(const u32x4*)(z + (size_t)t * 1024 + c8);
    u32x4 z0 = MK4(0, 0, 0, 0), z2 = MK4(0, 0, 0, 0);
    if (pos != 0) z0 = *(const u32x4*)(z + (size_t)(t - 1) * 1024 + c8);
    if (pos != L - 1) z2 = *(const u32x4*)(z + (size_t)(t + 1) * 1024 + c8);
    const unsigned bu[4] = {bv.x, bv.y, bv.z, bv.w}, u0[4] = {z0.x, z0.y, z0.z, z0.w}, u1[4] = {z1.x, z1.y, z1.z, z1.w}, u2[4] = {z2.x, z2.y, z2.z, z2.w};
    unsigned ou[4];
#pragma unroll
    for (int i = 0; i < 4; ++i) {
      const int c = c8 + 2 * i;
      const float lo = bflo(bu[i]) * (bflo(u0[i]) * cw[c] + bflo(u1[i]) * cw[1024 + c] + bflo(u2[i]) * cw[2048 + c]);
      const float hi = bfhi(bu[i]) * (bfhi(u0[i]) * cw[c + 1] + bfhi(u1[i]) * cw[1024 + c + 1] + bfhi(u2[i]) * cw[2048 + c + 1]);
      ou[i] = pk(lo, hi);
    }
    *(u32x4*)(bz + (size_t)t * 1024 + c8) = MK4(ou[0], ou[1], ou[2], ou[3]);
  }
}

template <int ROWS, int ROWB>
DI void stage_tile(const bf16_t* src, size_t rowstride, char* sm) {
  constexpr int CPR = ROWB / 16, NB = ROWS * CPR / 2048;
  const int tidv = opaque((int)threadIdx.x) & 255;
#pragma unroll
  for (int bq = 0; bq < NB; ++bq) {
    u32x4 v[8];
#pragma unroll
    for (int qq = 0; qq < 8; ++qq) {
      const int c = tidv + 256 * (bq * 8 + qq), row = c / CPR, kc = c % CPR;
      v[qq] = *(const u32x4*)(src + (size_t)row * rowstride + kc * 8);
    }
#pragma unroll
    for (int qq = 0; qq < 8; ++qq) {
      const int c = tidv + 256 * (bq * 8 + qq), row = c / CPR, kc = c % CPR;
      *(u32x2*)(sm + row * (ROWB + 8) + kc * 16) = MK2(v[qq].x, v[qq].y);
      *(u32x2*)(sm + row * (ROWB + 8) + kc * 16 + 8) = MK2(v[qq].z, v[qq].w);
    }
    __builtin_amdgcn_sched_barrier(0);
  }
}

DI void ret_scan_phase(const Params& p, int hf, char* smem) {
  char* ws_ = opqp(p.ws); float* out_ = opqp(p.out);
  const int tid0 = opaque((int)threadIdx.x), tid = tid0 & 255, vb = blockIdx.x * 2 + (tid0 >> 8), vg = gridDim.x * 2, lane = tid & 63, w = tid >> 6, r = lane & 31, h5 = lane >> 5;
  smem += (tid0 >> 8) * HALF_LDS;
  const int nseq = hf ? 4 : 32, seqlen = hf ? 2048 : 256, nchunks = seqlen >> 7;
  const int nitems = nseq * 32;
  const int spread = (nitems * 4 <= vg) ? 4 : 1;
  int item0 = vb, istep = vg;
  if (spread > 1) {
    const bool has = (vb % spread) == 0 && (vb / spread) < nitems;
    const int pvb = vb ^ 1;
    const bool phas = (pvb % spread) == 0 && (pvb / spread) < nitems;
    item0 = has ? vb / spread : nitems;
    istep = nitems;
    if (!has && phas) { for (int cs = 0; cs < nchunks; ++cs) { __syncthreads(); __syncthreads(); __syncthreads(); __syncthreads(); } }
    if (blockIdx.x & 1) {
      const int nb2 = gridDim.x >> 1;
      for (int it = p.conv_tiles_early + (int)(blockIdx.x >> 1); it < p.conv_tiles; it += nb2) convert_tile(p, smem - (tid0 >> 8) * HALF_LDS, it, tid0);
    }
  }
  for (int item = item0; item < nitems; item += istep) {
    const int es = item & 3, dir = (item >> 2) & 1, hd = (item >> 3) & 3, b = item >> 5;
    const float lg2 = -__expf(p.in[opqs(21)][dir * 4 + hd]) * LOG2E;
    const int tl0 = b * seqlen;
    const int ecol = hd * 512 + es * 128 + 32 * w + r;
    f32x16 S[8];
    if (hf) {
      const float* sp = p.in[opqs(6)] + ((size_t)((b * 2 + dir) * 4 + hd)) * 131072 + es * 128 + 32 * w + r;
#pragma unroll
      for (int db = 0; db < 8; ++db) {
        const float* spd = sp + (size_t)(opaque(4 * h5 * 512) + 32 * db * 512);
#pragma unroll
        for (int i = 0; i < 16; ++i) S[db][i] = spd[crow(i, 0) * 512];
        __builtin_amdgcn_sched_barrier(0);
      }
    } else {
#pragma unroll
      for (int db = 0; db < 8; ++db)
#pragma unroll
        for (int i = 0; i < 16; ++i) S[db][i] = 0.f;
    }
    const float cdecay = ex2(lg2 * 128.f);
#pragma unroll 1
    for (int cs = 0; cs < nchunks; ++cs) {
      const int c = dir ? nchunks - 1 - cs : cs;
      const int tc = tl0 + c * 128;
      const float cr_base = opaquef(lg2 * (dir ? (float)(128 - 4 * h5) : (float)(4 * h5 + 1)));
      const float cr_slope = opaquef(dir ? -lg2 : lg2);
      const float vw_base = opaquef(lg2 * (dir ? (float)(8 * h5) : (float)(127 - 8 * h5)));
      const float vw_slope = opaquef(dir ? lg2 : -lg2);
      const int ecolv = opaque(ecol);
      char* scrl = opqp(p.ws) + OFF_SCR;
      const bf16_t* rq = (const bf16_t*)(scrl + S_RQ);
      const bf16_t* rkT = (const bf16_t*)(scrl + S_RKT);
      const bf16_t* rvT = (const bf16_t*)(scrl + S_RVT);
      bf16_t* cross = (bf16_t*)(scrl + (dir ? S_CRB : S_CRF));
      __syncthreads();
      stage_tile<128, 512>(rq + (size_t)tc * 1024 + hd * 256, 1024, smem);
      __syncthreads();
      __builtin_amdgcn_sched_barrier(0);
#pragma unroll
      for (int ip = 0; ip < 4; ++ip) {
        f32x16 cacc;
#pragma unroll
        for (int i = 0; i < 16; ++i) cacc[i] = 0.f;
        {
          const char* qbase = smem + (32 * ip + r) * 520 + (4 * h5) * 2;
          u32x2 qlo[4], qhi[4];
#define CR_READ(i) do { const char* ap_ = qbase + (16 * (i)) * 2; qlo[(i) & 3] = *(const u32x2*)ap_; qhi[(i) & 3] = *(const u32x2*)(ap_ + 16); } while (0)
          CR_READ(0); CR_READ(1); CR_READ(2);
          __builtin_amdgcn_sched_barrier(0);
#pragma unroll
          for (int i = 0; i < 16; ++i) {
            if (i + 3 < 16) CR_READ(i + 3);
#pragma unroll
            for (int i8 = 0; i8 < 8; ++i8) { float t_ = S[i >> 1][8 * (i & 1) + i8]; asm volatile("" : "+v"(t_)); S[i >> 1][8 * (i & 1) + i8] = t_; }
            const bf16x8 bfr = PACK8(S[i >> 1], (i & 1));
            __builtin_amdgcn_sched_barrier(0);
            cacc = MFMA(mk8(qlo[i & 3], qhi[i & 3]), bfr, cacc);
            __builtin_amdgcn_sched_barrier(0);
          }
#undef CR_READ
        }
#pragma unroll
        for (int i = 0; i < 16; ++i) {
          const int ilc = 32 * ip + crow(i, 0);
          cross[(size_t)(tc + 4 * h5) * 2048 + ecolv + (size_t)ilc * 2048] = bf1(cacc[i] * ex2(__builtin_fmaf(cr_slope, (float)ilc, cr_base)));
        }
        __builtin_amdgcn_sched_barrier(0);
      }
      __syncthreads();
      stage_tile<256, 256>(rkT + (size_t)(hd * 256) * 8192 + tc, 8192, smem);
      __syncthreads();
      __builtin_amdgcn_sched_barrier(0);
#pragma unroll
      for (int db = 0; db < 8; ++db)
#pragma unroll
        for (int i = 0; i < 16; ++i) { float t_ = S[db][i]; asm volatile("v_mul_f32 %0, %0, %1" : "+v"(t_) : "v"(cdecay)); S[db][i] = t_; }
#pragma unroll
      for (int sh = 0; sh < 2; ++sh) {
        bf16x8 vf[4];
        {
          const bf16_t* vp = rvT + (size_t)ecolv * 8192 + tc + 8 * h5 + 64 * sh;
#pragma unroll
          for (int s = 0; s < 4; ++s) {
            const u32x4 raw = *(const u32x4*)(vp + 16 * s);
            const unsigned u[4] = {raw.x, raw.y, raw.z, raw.w};
            unsigned o4[4];
#pragma unroll
            for (int jj = 0; jj < 4; ++jj) {
              const int jc = 64 * sh + 16 * s + 2 * jj;
              o4[jj] = pk(bflo(u[jj]) * ex2(__builtin_fmaf(vw_slope, (float)jc, vw_base)), bfhi(u[jj]) * ex2(__builtin_fmaf(vw_slope, (float)(jc + 1), vw_base)));
            }
            vf[s] = mk8(MK4(o4[0], o4[1], o4[2], o4[3]));
          }
        }
        __builtin_amdgcn_sched_barrier(0);
        {
          const char* abase = smem + r * 264 + (64 * sh + 8 * h5) * 2;
          u32x2 rlo[4], rhi[4];
#define ST_READ(i) do { const char* ap_ = abase + (32 * ((i) >> 2)) * 264 + (16 * ((i) & 3)) * 2; rlo[(i) & 3] = *(const u32x2*)ap_; rhi[(i) & 3] = *(const u32x2*)(ap_ + 8); } while (0)
          ST_READ(0); ST_READ(1); ST_READ(2);
          __builtin_amdgcn_sched_barrier(0);
#pragma unroll
          for (int i = 0; i < 32; ++i) {
            if (i + 3 < 32) ST_READ(i + 3);
            __builtin_amdgcn_sched_barrier(0);
            S[i >> 2] = MFMA(mk8(rlo[i & 3], rhi[i & 3]), vf[i & 3], S[i >> 2]);
            __builtin_amdgcn_sched_barrier(0);
          }
#undef ST_READ
        }
      }
      __builtin_amdgcn_sched_barrier(0);
    }
    if (!hf) {
      float* so = out_ + OUT_STATE + ((size_t)((b * 2 + dir) * 4 + hd)) * 131072 + es * 128 + 32 * w + r;
#pragma unroll
      for (int db = 0; db < 8; ++db) {
        float* sod = so + (size_t)(opaque(4 * h5 * 512) + 32 * db * 512);
#pragma unroll
        for (int i = 0; i < 16; ++i) sod[crow(i, 0) * 512] = S[db][i];
        __builtin_amdgcn_sched_barrier(0);
      }
    }
  }
}

DI void ret_intra_phase(const Params& p, int hf, char* smem) {
  char* ws_ = opqp(p.ws); float* out_ = opqp(p.out);
  const int tid0 = opaque((int)threadIdx.x), tid = tid0 & 255, vb = blockIdx.x * 2 + (tid0 >> 8), vg = gridDim.x * 2, lane = tid & 63, w = tid >> 6, r = lane & 31, h5 = lane >> 5;
  smem += (tid0 >> 8) * HALF_LDS;
  const bf16_t* rq = (const bf16_t*)(ws_ + OFF_SCR + S_RQ);
  const bf16_t* rk = (const bf16_t*)(ws_ + OFF_SCR + S_RK);
  const bf16_t* rvT = (const bf16_t*)(ws_ + OFF_SCR + S_RVT);
  const bf16_t* crf = (const bf16_t*)(ws_ + OFF_SCR + S_CRF);
  const bf16_t* crb = (const bf16_t*)(ws_ + OFF_SCR + S_CRB);
  bf16_t* sgy = (bf16_t*)(ws_ + OFF_SCR + S_SGY) + (size_t)hf * 8192 * 2048;
  const float* gn = p.in[opqs(22)];
  u32x4* sP = (u32x4*)smem;
  f32x2* sStat = (f32x2*)(smem + 8192);
  for (int item = vb; item < 1024; item += vg) {
    const int hd = item & 3, tb = item >> 2, t0 = tb * 32, tc = t0 & ~127;
    const float lgf2 = -__expf(p.in[opqs(21)][hd]) * LOG2E, lgb2 = -__expf(p.in[opqs(21)][4 + hd]) * LOG2E;
    f32x16 pt;
#pragma unroll
    for (int i = 0; i < 16; ++i) pt[i] = 0.f;
    {
      const bf16_t* kp = rk + (size_t)(tc + 32 * w + r) * 1024 + hd * 256 + 8 * h5;
      const bf16_t* qp = rq + (size_t)(t0 + r) * 1024 + hd * 256 + 8 * h5;
#pragma unroll
      for (int bt = 0; bt < 2; ++bt) {
        bf16x8 kf[8], qv[8];
#pragma unroll
        for (int s = 0; s < 8; ++s) { kf[s] = *(const bf16x8*)(kp + 16 * (8 * bt + s)); qv[s] = *(const bf16x8*)(qp + 16 * (8 * bt + s)); }
        __builtin_amdgcn_sched_barrier(0);
#pragma unroll
        for (int s = 0; s < 8; ++s) pt = MFMA(kf[s], qv[s], pt);
        __builtin_amdgcn_sched_barrier(0);
      }
    }
    const int il = (t0 - tc) + r;
#pragma unroll
    for (int i = 0; i < 16; ++i) {
      const int j = 32 * w + crow(i, h5), diff = il - j;
      const float dec = diff > 0 ? ex2(lgf2 * (float)diff) : (diff < 0 ? ex2(lgb2 * (float)(-diff)) : 2.f);
      pt[i] *= dec;
    }
    __syncthreads();
    {
      const bf16x8 f0 = PACK8(pt, 0), f1 = PACK8(pt, 1);
      sP[(w * 2 + 0) * 64 + lane] = __builtin_bit_cast(u32x4, f0);
      sP[(w * 2 + 1) * 64 + lane] = __builtin_bit_cast(u32x4, f1);
    }
    __syncthreads();
    f32x16 o[4];
    {
      u32x4 bq[8];
#pragma unroll
      for (int q = 0; q < 8; ++q) bq[q] = sP[q * 64 + lane];
      u32x2 va[2][8], vb[2][8];
#define IV_LOAD(buf, eb_) do { const bf16_t* vrow_ = rvT + (size_t)(hd * 512 + 128 * w + 32 * (eb_) + r) * 8192 + tc + 4 * h5; \
        _Pragma("unroll") for (int q = 0; q < 8; ++q) { va[buf][q] = *(const u32x2*)(vrow_ + 16 * q); vb[buf][q] = *(const u32x2*)(vrow_ + 16 * q + 8); } } while (0)
      IV_LOAD(0, 0);
#pragma unroll
      for (int eb = 0; eb < 4; ++eb) {
        if (eb + 1 < 4) IV_LOAD((eb + 1) & 1, eb + 1);
        __builtin_amdgcn_sched_barrier(0);
#pragma unroll
        for (int i = 0; i < 16; ++i) o[eb][i] = 0.f;
#pragma unroll
        for (int q = 0; q < 8; ++q) o[eb] = MFMA(mk8(va[eb & 1][q], vb[eb & 1][q]), mk8(bq[q]), o[eb]);
        __builtin_amdgcn_sched_barrier(0);
      }
#undef IV_LOAD
    }
    const int t = t0 + r;
    float sum = 0.f, sq = 0.f;
    u32x2 cfv[16], cbv[16], sgv[16];
    {
      const size_t rowoff = (size_t)t * 2048 + hd * 512 + 128 * w + 4 * h5;
#pragma unroll
      for (int q = 0; q < 16; ++q) {
        cfv[q] = *(const u32x2*)(crf + rowoff + 8 * q);
        cbv[q] = *(const u32x2*)(crb + rowoff + 8 * q);
        sgv[q] = *(const u32x2*)(sgy + rowoff + 8 * q);
      }
    }
    __builtin_amdgcn_sched_barrier(0);
#pragma unroll
    for (int eb = 0; eb < 4; ++eb)
#pragma unroll
      for (int g = 0; g < 4; ++g) {
        const u32x2 cf = cfv[4 * eb + g], cb = cbv[4 * eb + g];
        o[eb][4 * g] += bflo(cf.x) + bflo(cb.x);
        o[eb][4 * g + 1] += bfhi(cf.x) + bfhi(cb.x);
        o[eb][4 * g + 2] += bflo(cf.y) + bflo(cb.y);
        o[eb][4 * g + 3] += bfhi(cf.y) + bfhi(cb.y);
#pragma unroll
        for (int jj = 0; jj < 4; ++jj) { const float v = o[eb][4 * g + jj]; sum += v; sq += v * v; }
      }
    f32x4 gnv[16];
#pragma unroll
    for (int q = 0; q < 16; ++q) gnv[q] = *(const f32x4*)(gn + hd * 512 + 128 * w + 4 * h5 + 8 * q);
    sum += shx(sum, 32, lane);
    sq += shx(sq, 32, lane);
    if (h5 == 0) sStat[w * 32 + r] = MKF2(sum, sq);
    __syncthreads();
    float ts = 0.f, tq = 0.f;
#pragma unroll
    for (int ww = 0; ww < 4; ++ww) { const f32x2 v = sStat[ww * 32 + r]; ts += v.x; tq += v.y; }
    const float mu = ts * (1.f / 512.f);
    const float var = fmaxf(tq * (1.f / 512.f) - mu * mu, 0.f);
    const float rstd = rsqrtf(var + 1e-6f);
#pragma unroll
    for (int eb = 0; eb < 4; ++eb)
#pragma unroll
      for (int g = 0; g < 4; ++g) {
        const int e = hd * 512 + 128 * w + 32 * eb + 8 * g + 4 * h5;
        bf16_t* yp = sgy + (size_t)t * 2048 + e;
        const u32x2 sg = sgv[4 * eb + g];
        const f32x4 gg = gnv[4 * eb + g];
        *(u32x2*)yp = pack4((o[eb][4 * g] - mu) * rstd * gg.x * bflo(sg.x), (o[eb][4 * g + 1] - mu) * rstd * gg.y * bfhi(sg.x),
                            (o[eb][4 * g + 2] - mu) * rstd * gg.z * bflo(sg.y), (o[eb][4 * g + 3] - mu) * rstd * gg.w * bfhi(sg.y));
      }
  }
}


#define XB_TMO      128
#define XB_XCNT(j)  (256  + 64 * (j))
#define XB_XSUB(j)  (1280 + 64 * (j))
#define XB_XGEN(j)  (2304 + 64 * (j))
#define XB_TOP      3328
#define XB_TOPGEN   3392
#define XCD_BAR_WORDS 3456
#define XB_SPIN_CAP (1u << 22)
#define LAS __attribute__((address_space(3)))
DI unsigned xb_ld(unsigned* p) { return __hip_atomic_load(p, __ATOMIC_RELAXED, __HIP_MEMORY_SCOPE_AGENT); }
DI unsigned xb_add(unsigned* p, unsigned v) { return __hip_atomic_fetch_add(p, v, __ATOMIC_RELAXED, __HIP_MEMORY_SCOPE_AGENT); }
DI unsigned xb_xcc_id() { return (unsigned)__builtin_amdgcn_s_getreg((3 << 11) | 20) & 0xFu; }
#define XB_SPIN(cond, bar) do { unsigned _sp = 0; while (cond) { __builtin_amdgcn_s_sleep(1); \
    if ((++_sp & 255u) == 0u) { if (xb_ld(&(bar)[XB_TMO])) break; if (_sp > XB_SPIN_CAP) { atomicAdd(&(bar)[XB_TMO], 1u); break; } } } } while (0)
DI void xcd_barrier_complete(unsigned* bar, unsigned x, unsigned& nloc, unsigned& nx) {
  const unsigned G = gridDim.x;
  unsigned sum, cnt, mine, sp = 0u;
  for (;;) {
    sum = 0u; cnt = 0u; mine = 0u;
#pragma unroll
    for (unsigned j = 0; j < 16; ++j) { const unsigned c = xb_ld(&bar[XB_XCNT(j)]); sum += c; cnt += (c > 0u) ? 1u : 0u; mine = (j == x) ? c : mine; }
    if (sum == G) break;
    __builtin_amdgcn_s_sleep(1);
    if ((++sp & 255u) == 0u) { if (xb_ld(&bar[XB_TMO])) break; if (sp > XB_SPIN_CAP) { atomicAdd(&bar[XB_TMO], 1u); break; } }
  }
  nloc = mine > 0u ? mine : 1u; nx = cnt > 0u ? cnt : 1u;
}
DI void xcd_barrier(unsigned* bar, volatile LAS unsigned* st) {
  asm volatile("s_waitcnt vmcnt(0)" ::: "memory");
  __syncthreads();
  if (threadIdx.x == 0) {
    const unsigned x = xb_xcc_id();
    __builtin_amdgcn_s_waitcnt(0);
    unsigned nloc = st[0], nx = st[1];
    if (nloc == 0u) { xcd_barrier_complete(bar, x, nloc, nx); st[0] = nloc; st[1] = nx; }
    const unsigned old = xb_add(&bar[XB_XSUB(x)], 1u);
    const unsigned gen = old / nloc;
    if (old + 1u == (gen + 1u) * nloc) {
      __builtin_amdgcn_fence(__ATOMIC_RELEASE, "agent");
      asm volatile("s_waitcnt vmcnt(0)" ::: "memory");
      const unsigned og = xb_add(&bar[XB_TOP], 1u);
      const unsigned tg = og / nx;
      if (og + 1u == (tg + 1u) * nx) xb_add(&bar[XB_TOPGEN], 1u);
      else XB_SPIN(xb_ld(&bar[XB_TOPGEN]) == tg, bar);
      __builtin_amdgcn_fence(__ATOMIC_ACQUIRE, "agent");
      xb_add(&bar[XB_XGEN(x)], 1u);
      asm volatile("s_waitcnt vmcnt(0)" ::: "memory");
    } else {
      XB_SPIN(xb_ld(&bar[XB_XGEN(x)]) == gen, bar);
      __builtin_amdgcn_fence(__ATOMIC_ACQUIRE, "agent");
      asm volatile("s_waitcnt vmcnt(0)" ::: "memory");
    }
  }
  __syncthreads();
}

#define PHASE_END() do { if (++ph >= p.nph) return; xcd_barrier(bar, xst); } while (0)

__global__ void __launch_bounds__(512) fwd_megakernel(const Params p) {
  cg::grid_group grid = cg::this_grid();
  __shared__ __attribute__((aligned(16))) char smem[SMEM_BYTES];
  __shared__ uint4 xb_words;
  unsigned* bar = (unsigned*)(p.ws + OFF_BAR);
  volatile LAS unsigned* xst = (volatile LAS unsigned*)&xb_words;
  if (threadIdx.x == 0) { xb_words = make_uint4(0u, 0u, 0u, 0u); (void)xb_add(&bar[XB_XCNT(xb_xcc_id())], 1u); }
  __syncthreads();
  int ph = 0;

  prep_phase(p, smem);
  if (++ph >= p.nph) return;
  grid.sync();


#pragma unroll 1
  for (int layer = 0; layer < 4; ++layer) {
    const int kind = layer % 3, j = layer / 3;
#define wsl (opqp(p.ws))
#define scr (opqp(p.ws) + OFF_SCR)
#define wt ((bf16_t*)(opqp(p.ws) + OFF_WT))
#define h ((bf16_t*)(opqp(p.ws) + OFF_H))
#define mod ((const float*)(opqp(p.ws) + OFF_MOD))
#define x (opqp(p.out))
    if (layer == 0) { norm_phase(p, 0, 0); PHASE_END(); }
    EpiArgs ea;
#define EA_FUSE(which) do { const int ridx_ = layer * 2 + (which); ea.f1 = (float*)(wsl + OFF_RSS) + (size_t)ridx_ * T_TOK; \
      ea.u0 = (unsigned*)(wsl + OFF_BAR) + CNT_WORD0 + ridx_ * 64; ea.b5 = h; \
      if ((which) == 0) { ea.c1 = p.in[opqs(10)] + layer * 1024; ea.c2 = mod + (size_t)layer * 5 * 6144 + 3 * 1024; ea.i0 = 0; } \
      else if (layer < 3) { ea.c1 = p.in[opqs(9)] + (layer + 1) * 1024; ea.c2 = mod + (size_t)(layer + 1) * 5 * 6144; ea.i0 = 0; } \
      else { ea.c1 = p.in[opqs(26)]; ea.c2 = mod; ea.i0 = 1; } } while (0)
    if (kind == 0) {
      const bf16_t* w_a = wt + (size_t)j * 786432;
      const bf16_t* w_qb = wt + 1572864 + (size_t)j * 589824;
      const bf16_t* w_kvb = wt + 2752512 + (size_t)j * 524288;
      const bf16_t* w_o = wt + 3801088 + (size_t)j * 1048576;
      ea = EpiArgs{}; ea.f0 = (float*)(scr + S_A);
      gemm_phase<EPI_F32>(h, 1024, w_a, 1024, T_TOK, 768, ea, smem);
      PHASE_END();
      mla_post_phase(p, j);
      PHASE_END();
      ea = EpiArgs{}; ea.b0 = (bf16_t*)(scr + S_Q); ea.c0 = (const float*)(wsl + OFF_CS);
      gemm_phase<EPI_Q>((const bf16_t*)(scr + S_QAN), 384, w_qb, 384, T_TOK, 1536, ea, smem);
      ea = EpiArgs{}; ea.b0 = (bf16_t*)(scr + S_KNOPE); ea.b1 = (bf16_t*)(scr + S_VT);
      gemm_phase<EPI_KV>((const bf16_t*)(scr + S_CKVN), 256, w_kvb, 256, KVROWS, 2048, ea, smem);
      PHASE_END();
      attn_phase(p, smem);
      PHASE_END();
      ea = EpiArgs{}; ea.f0 = x; ea.c0 = mod + (size_t)layer * 5 * 6144 + 2 * 1024; EA_FUSE(0);
      gemm_phase<EPI_RESIDN>((const bf16_t*)(scr + S_A), 1024, w_o, 1024, T_TOK, 1024, ea, smem);
      PHASE_END();
    } else if (kind == 1) {
      const bf16_t* w_in = wt + 5898240;
      const bf16_t* w_out = wt + 9043968;
      ea = EpiArgs{}; ea.b0 = (bf16_t*)(scr + S_BB); ea.b1 = (bf16_t*)(scr + S_Z);
      gemm_phase<EPI_CONV>(h, 1024, w_in, 1024, T_TOK, 3072, ea, smem);
      PHASE_END();
      conv_phase(p);
      PHASE_END();
      ea = EpiArgs{}; ea.f0 = x; ea.c0 = mod + (size_t)layer * 5 * 6144 + 2 * 1024; EA_FUSE(0);
      gemm_phase<EPI_RESIDN>((const bf16_t*)(scr + S_BZ), 1024, w_out, 1024, T_TOK, 1024, ea, smem);
      PHASE_END();
    } else {
      const bf16_t* w_in = wt + 10092544;
      const bf16_t* w_out = wt + 16384000;
#pragma unroll 1
      for (int hf = 0; hf < 2; ++hf) {
        ea = EpiArgs{}; ea.b0 = (bf16_t*)(scr + S_RQ); ea.b1 = (bf16_t*)(scr + S_RK); ea.b2 = (bf16_t*)(scr + S_RKT); ea.b3 = (bf16_t*)(scr + S_RVT);
        ea.b4 = (bf16_t*)(scr + S_SGY); ea.i0 = hf * 8192;
        gemm_phase<EPI_RET>(h + (size_t)hf * 8192 * 1024, 1024, w_in, 1024, 8192, 6144, ea, smem);
        PHASE_END();
        ret_scan_phase(p, hf, smem);
        PHASE_END();
        ret_intra_phase(p, hf, smem);
        PHASE_END();
      }
      ea = EpiArgs{}; ea.f0 = x; ea.c0 = mod + (size_t)layer * 5 * 6144 + 2 * 1024; EA_FUSE(0);
      gemm_phase<EPI_RESIDN>((const bf16_t*)(scr + S_SGY), 2048, w_out, 2048, T_TOK, 1024, ea, smem);
      PHASE_END();
    }
    ea = EpiArgs{}; ea.b0 = (bf16_t*)(scr + S_HID);
    gemm_phase<EPI_SWIGLU>(h, 1024, wt + 18481152 + (size_t)layer * 5767168, 1024, T_TOK, 5632, ea, smem);
    PHASE_END();
    ea = EpiArgs{}; ea.f0 = x; ea.c0 = mod + (size_t)layer * 5 * 6144 + 5 * 1024; EA_FUSE(1);
    gemm_phase<EPI_RESIDN>((const bf16_t*)(scr + S_HID), 2816, wt + 41549824 + (size_t)layer * 2883584, 2816, T_TOK, 1024, ea, smem);
    if (layer < 3) PHASE_END();
  }
}

#undef wsl
#undef scr
#undef wt
#undef h
#undef mod
#undef x
extern "C" void kernel_launch(void* const* d_in, const int* in_sizes, int n_in, void* d_out, int out_size, void* d_ws, size_t ws_size, hipStream_t stream) {
  static int grid_blocks = 0;
  if (!grid_blocks) {
    int dev = 0, cus = 0, per_cu = 0;
    (void)hipGetDevice(&dev);
    (void)hipDeviceGetAttribute(&cus, hipDeviceAttributeMultiprocessorCount, dev);
    (void)hipOccupancyMaxActiveBlocksPerMultiprocessor(&per_cu, fwd_megakernel, 512, 0);
    if (per_cu > 1) per_cu = 1;
    grid_blocks = cus * per_cu;
  }
  if (ws_size < WS_NEED) { fprintf(stderr, "workspace too small: %zu < %zu\n", ws_size, (size_t)WS_NEED); return; }
  Params p;
  memset(&p, 0, sizeof(p));
  for (int i = 0; i < 27; ++i) p.in[i] = (const float*)d_in[i];
  p.out = (float*)d_out;
  p.ws = (char*)d_ws;
  bf16_t* wt = (bf16_t*)((char*)d_ws + OFF_WT);
  int nd = 0, tiles = 0;
  auto add = [&](const float* src, size_t dst_off, int K, int N, int Npad, int mode) {
    ConvDesc& d = p.cd[nd++];
    d.src = src; d.dst = wt + dst_off; d.K = K; d.N = N; d.Npad = Npad; d.mode = mode; d.tile0 = tiles; d.pad = 0;
    tiles += (Npad / 64) * (K / 64);
  };
  const float* const* in = (const float* const*)d_in;
  const size_t O_WA = 0, O_WQB = 1572864, O_WKVB = 2752512, O_WO = 3801088, O_CIN = 5898240, O_COUT = 9043968, O_RIN = 10092544, O_ROUT = 16384000,
               O_F1 = 18481152, O_F2 = 41549824;
  auto add_mla = [&](int j) {
    add(in[11] + (size_t)j * 1024 * 704, O_WA + (size_t)j * 786432, 1024, 704, 768, 0);
    add(in[14] + (size_t)j * 384 * 1536, O_WQB + (size_t)j * 589824, 384, 1536, 1536, 0);
    add(in[15] + (size_t)j * 256 * 2048, O_WKVB + (size_t)j * 524288, 256, 2048, 2048, 0);
    add(in[16] + (size_t)j * 1024 * 1024, O_WO + (size_t)j * 1048576, 1024, 1024, 1024, 0);
  };
  auto add_ffn = [&](int i) {
    add(in[24] + (size_t)i * 1024 * 5632, O_F1 + (size_t)i * 5767168, 1024, 5632, 5632, 2);
    add(in[25] + (size_t)i * 2816 * 1024, O_F2 + (size_t)i * 2883584, 2816, 1024, 1024, 0);
  };
  add_mla(0);
  add(in[17], O_CIN, 1024, 3072, 3072, 1);
  add(in[19], O_COUT, 1024, 1024, 1024, 0);
  add(in[20], O_RIN, 1024, 6144, 6144, 0);
  add(in[23], O_ROUT, 2048, 1024, 1024, 0);
  add_ffn(0); add_ffn(1);
  p.conv_tiles_early = tiles;
  add_ffn(2); add_ffn(3);
  add_mla(1);
  p.conv_tiles = tiles;
  if (grid_blocks * 2 < 512) p.conv_tiles_early = tiles;
  p.nph = 1000;
  p.dup = 0;
  (void)hipMemsetAsync((char*)d_ws + OFF_BAR, 0, 16384, stream);
  void* args[] = {&p};
  hipError_t e = hipLaunchCooperativeKernel((void*)fwd_megakernel, dim3(grid_blocks), dim3(512), args, 0, stream);
  if (e != hipSuccess) fprintf(stderr, "cooperative launch failed: %s (grid %d)\n", hipGetErrorString(e), grid_blocks);
}
```
